# Optimizing an MI355X kernel written in HIP

```python
import math
import jax, jax.numpy as jnp
from jax import lax
import numpy as np

D_MODEL = 1024
BATCH = 8
SEQ = 2048
DEPTH = 1

HEAD_DIM = 64
NSA_HEADS = 8
NSA_KV_HEADS = 2
NSA_WIDTH = NSA_HEADS * HEAD_DIM
KV_WIDTH = NSA_KV_HEADS * HEAD_DIM
CONV_CH = D_MODEL - NSA_WIDTH
CMP_LEN = 32
CMP_STRIDE = 16
CMP_HIDDEN = 4 * HEAD_DIM
SLC_BLOCK = 64
SLC_TOPN = 8
WINDOW = 512
Q_BLOCK = 128
CONV_WIDTH = 31
FFN_HIDDEN = -(-8 * D_MODEL // (3 * 256)) * 256
ROPE_THETA = 10000.0
EPS = 1e-6
NEG = -1e30
FORCE = 1e6
IN_WIDTH = NSA_WIDTH + 6 * KV_WIDTH + 3 * NSA_HEADS + 2 * CONV_CH

kernel_name = "hymba_nsa_conformer_conv_hybrid"


def rms_norm(x, g):
    xf = x.astype(jnp.float32)
    y = xf * lax.rsqrt(jnp.mean(xf * xf, axis=-1, keepdims=True) + EPS)
    return (y * g.astype(jnp.float32)).astype(x.dtype)


def rope(x, pos):
    half = HEAD_DIM // 2
    inv = ROPE_THETA ** (-jnp.arange(half, dtype=jnp.float32) / half)
    ang = pos.astype(jnp.float32)[:, None] * inv[None, :]
    cos, sin = jnp.cos(ang), jnp.sin(ang)
    xf = x.astype(jnp.float32)
    x1, x2 = xf[..., :half], xf[..., half:]
    return jnp.concatenate([x1 * cos - x2 * sin, x2 * cos + x1 * sin], axis=-1).astype(x.dtype)


def masked_softmax(s, m):
    p = jax.nn.softmax(jnp.where(m, s, NEG), axis=-1)
    return jnp.where(m, p, 0.0)


def n_cmp_blocks(seq):
    return (seq - CMP_LEN) // CMP_STRIDE + 1


def cmp_to_slc_overlap(seq):
    cs = np.arange(n_cmp_blocks(seq))[:, None] * CMP_STRIDE
    ss = np.arange(seq // SLC_BLOCK)[None, :] * SLC_BLOCK
    ov = np.clip(np.minimum(cs + CMP_LEN, ss + SLC_BLOCK) - np.maximum(cs, ss), 0, None)
    return (ov / CMP_LEN).astype(np.float32)


def compress(t, pe, w1, w2):
    b, g, s, hd = t.shape
    ncmp = n_cmp_blocks(s)
    idx = np.arange(ncmp)[:, None] * CMP_STRIDE + np.arange(CMP_LEN)[None, :]
    blocks = t[:, :, idx] + pe
    flat = blocks.reshape(b, g, ncmp, CMP_LEN * hd)
    return jax.nn.silu(flat @ w1) @ w2


def nsa_attention(q, kc, vc, ks, vs, kw, vw, gates):
    b, h, s, hd = q.shape
    g = kc.shape[1]
    r = h // g
    nb = s // SLC_BLOCK
    n_sel = min(SLC_TOPN, nb)
    n_qb = s // Q_BLOCK
    ncmp = kc.shape[2]
    overlap = jnp.asarray(cmp_to_slc_overlap(s))
    cmp_end = jnp.arange(ncmp) * CMP_STRIDE + CMP_LEN - 1
    scale = HEAD_DIM ** -0.5
    kcf, vcf = kc.astype(jnp.float32), vc.astype(jnp.float32)
    ks_blk = ks.reshape(b, g, nb, SLC_BLOCK, hd)
    vs_blk = vs.reshape(b, g, nb, SLC_BLOCK, hd)
    kw_pad = jnp.pad(kw, ((0, 0), (0, 0), (WINDOW, 0), (0, 0)))
    vw_pad = jnp.pad(vw, ((0, 0), (0, 0), (WINDOW, 0), (0, 0)))
    qb = q.reshape(b, g, r, n_qb, Q_BLOCK, hd).transpose(3, 0, 1, 2, 4, 5)
    gb = gates.reshape(b, g, r, n_qb, Q_BLOCK, 3).transpose(3, 0, 1, 2, 4, 5)
    bi = jnp.arange(b)[:, None, None, None]
    gi = jnp.arange(g)[None, :, None, None]
    blk = jnp.arange(nb)

    def block_fn(args):
        c, qc, gc = args
        t = c * Q_BLOCK + jnp.arange(Q_BLOCK)
        qf = qc.astype(jnp.float32) * scale
        s_c = jnp.einsum('bgrqd,bgnd->bgrqn', qf, kcf)
        p_c = masked_softmax(s_c, cmp_end[None, :] <= t[:, None])
        o_c = jnp.einsum('bgrqn,bgnd->bgrqd', p_c, vcf)
        imp = jnp.einsum('bgrqn,nj->bgqj', p_c, overlap)
        cur = t // SLC_BLOCK
        valid = blk[None, :] <= cur[:, None]
        forced = (blk[None, :] == 0) | (blk[None, :] == cur[:, None]) | (blk[None, :] == cur[:, None] - 1)
        score = jnp.where(valid, imp + jnp.where(forced, FORCE, 0.0), -FORCE)
        top_val, top_idx = lax.top_k(score, n_sel)
        k_sel = ks_blk[bi, gi, top_idx].astype(jnp.float32)
        v_sel = vs_blk[bi, gi, top_idx].astype(jnp.float32)
        tok = top_idx[..., None] * SLC_BLOCK + jnp.arange(SLC_BLOCK)
        m_s = (tok <= t[None, None, :, None, None]) & (top_val > -1.0)[..., None]
        s_s = jnp.einsum('bgrqd,bgqnld->bgrqnl', qf, k_sel).reshape(b, g, r, Q_BLOCK, n_sel * SLC_BLOCK)
        p_s = masked_softmax(s_s, m_s.reshape(b, g, 1, Q_BLOCK, n_sel * SLC_BLOCK))
        o_s = jnp.einsum('bgrqk,bgqkd->bgrqd', p_s, v_sel.reshape(b, g, Q_BLOCK, n_sel * SLC_BLOCK, hd))
        start = c * Q_BLOCK
        k_win = lax.dynamic_slice_in_dim(kw_pad, start, WINDOW + Q_BLOCK, axis=2).astype(jnp.float32)
        v_win = lax.dynamic_slice_in_dim(vw_pad, start, WINDOW + Q_BLOCK, axis=2).astype(jnp.float32)
        kpos = start - WINDOW + jnp.arange(WINDOW + Q_BLOCK)
        m_w = (kpos[None, :] <= t[:, None]) & (kpos[None, :] > t[:, None] - WINDOW) & (kpos[None, :] >= 0)
        s_w = jnp.einsum('bgrqd,bgkd->bgrqk', qf, k_win)
        o_w = jnp.einsum('bgrqk,bgkd->bgrqd', masked_softmax(s_w, m_w), v_win)
        o = gc[..., 0:1] * o_c + gc[..., 1:2] * o_s + gc[..., 2:3] * o_w
        return o.astype(q.dtype)

    out = lax.map(block_fn, (jnp.arange(n_qb), qb, gb))
    out = out.transpose(1, 2, 3, 0, 4, 5).reshape(b, h, s, hd)
    return out.transpose(0, 2, 1, 3).reshape(b, s, h * hd)


def conformer_conv(u, w_dw, b_dw, ln_g, ln_b):
    a, gate = jnp.split(u, 2, axis=-1)
    hcv = a * jax.nn.sigmoid(gate)
    hcv = lax.conv_general_dilated(hcv, w_dw, window_strides=(1,), padding=[(CONV_WIDTH - 1, 0)],
                                   dimension_numbers=('NWC', 'WIO', 'NWC'), feature_group_count=CONV_CH) + b_dw
    hf = hcv.astype(jnp.float32)
    mu = jnp.mean(hf, axis=-1, keepdims=True)
    var = jnp.mean(jnp.square(hf - mu), axis=-1, keepdims=True)
    hn = (hf - mu) * lax.rsqrt(var + EPS) * ln_g.astype(jnp.float32) + ln_b.astype(jnp.float32)
    return jax.nn.silu(hn).astype(u.dtype)


def setup_inputs(seed: int = 0) -> dict:
    key = jax.random.key(seed)
    ks = jax.random.split(key, 24)
    f32 = jnp.float32
    L = DEPTH

    def nrm(k, shape, scale):
        return jax.random.normal(k, shape, f32) * scale

    def gain(k, n):
        return 1.0 + 0.02 * jax.random.normal(k, (L, n), f32)

    return {
        "x": jax.random.normal(ks[0], (BATCH, SEQ, D_MODEL), f32),
        "attn_norm_g": gain(ks[1], D_MODEL),
        "w_in": nrm(ks[2], (L, D_MODEL, IN_WIDTH), D_MODEL ** -0.5),
        "q_norm_g": gain(ks[3], HEAD_DIM),
        "k_norm_cmp_g": gain(ks[4], HEAD_DIM),
        "k_norm_slc_g": gain(ks[5], HEAD_DIM),
        "k_norm_win_g": gain(ks[6], HEAD_DIM),
        "cmp_pe_k": nrm(ks[7], (L, CMP_LEN, HEAD_DIM), 0.1),
        "cmp_w1_k": nrm(ks[8], (L, CMP_LEN * HEAD_DIM, CMP_HIDDEN), (CMP_LEN * HEAD_DIM) ** -0.5),
        "cmp_w2_k": nrm(ks[9], (L, CMP_HIDDEN, HEAD_DIM), CMP_HIDDEN ** -0.5),
        "cmp_pe_v": nrm(ks[10], (L, CMP_LEN, HEAD_DIM), 0.1),
        "cmp_w1_v": nrm(ks[11], (L, CMP_LEN * HEAD_DIM, CMP_HIDDEN), (CMP_LEN * HEAD_DIM) ** -0.5),
        "cmp_w2_v": nrm(ks[12], (L, CMP_HIDDEN, HEAD_DIM), CMP_HIDDEN ** -0.5),
        "conv_dw_w": nrm(ks[13], (L, CONV_WIDTH, 1, CONV_CH), CONV_WIDTH ** -0.5),
        "conv_dw_b": nrm(ks[14], (L, CONV_CH), 0.02),
        "conv_ln_g": gain(ks[15], CONV_CH),
        "conv_ln_b": nrm(ks[16], (L, CONV_CH), 0.02),
        "out_norm_nsa_g": gain(ks[17], NSA_WIDTH),
        "out_norm_conv_g": gain(ks[18], CONV_CH),
        "w_out": nrm(ks[19], (L, D_MODEL, D_MODEL), D_MODEL ** -0.5),
        "ffn_norm_g": gain(ks[20], D_MODEL),
        "w_gate_up": nrm(ks[21], (L, D_MODEL, 2 * FFN_HIDDEN), D_MODEL ** -0.5),
        "w_down": nrm(ks[22], (L, FFN_HIDDEN, D_MODEL), FFN_HIDDEN ** -0.5),
    }


def reference(x, attn_norm_g, w_in, q_norm_g, k_norm_cmp_g, k_norm_slc_g, k_norm_win_g,
              cmp_pe_k, cmp_w1_k, cmp_w2_k, cmp_pe_v, cmp_w1_v, cmp_w2_v,
              conv_dw_w, conv_dw_b, conv_ln_g, conv_ln_b, out_norm_nsa_g, out_norm_conv_g,
              w_out, ffn_norm_g, w_gate_up, w_down):
    b, s, _ = x.shape
    pos = jnp.arange(s)
    cmp_pos = jnp.arange(n_cmp_blocks(s)) * CMP_STRIDE + CMP_LEN - 1
    offs = list(np.cumsum([NSA_WIDTH] + [KV_WIDTH] * 6 + [3 * NSA_HEADS]))

    def heads(t, n):
        return t.reshape(b, s, n, HEAD_DIM).transpose(0, 2, 1, 3)

    for l in range(DEPTH):
        xn = rms_norm(x, attn_norm_g[l])
        proj = xn @ w_in[l]
        q, kc_raw, vc_raw, ks_, vs_, kw_, vw_, gate_logits, conv_in = jnp.split(proj, offs, axis=-1)
        q = rope(rms_norm(heads(q, NSA_HEADS), q_norm_g[l]), pos)
        k_slc = rope(rms_norm(heads(ks_, NSA_KV_HEADS), k_norm_slc_g[l]), pos)
        k_win = rope(rms_norm(heads(kw_, NSA_KV_HEADS), k_norm_win_g[l]), pos)
        k_cmp = compress(heads(kc_raw, NSA_KV_HEADS), cmp_pe_k[l], cmp_w1_k[l], cmp_w2_k[l])
        k_cmp = rope(rms_norm(k_cmp, k_norm_cmp_g[l]), cmp_pos)
        v_cmp = compress(heads(vc_raw, NSA_KV_HEADS), cmp_pe_v[l], cmp_w1_v[l], cmp_w2_v[l])
        gates = jax.nn.sigmoid(gate_logits.astype(jnp.float32)).reshape(b, s, NSA_HEADS, 3).transpose(0, 2, 1, 3)
        o_nsa = nsa_attention(q, k_cmp, v_cmp, k_slc, heads(vs_, NSA_KV_HEADS), k_win,
                              heads(vw_, NSA_KV_HEADS), gates)
        o_conv = conformer_conv(conv_in, conv_dw_w[l], conv_dw_b[l], conv_ln_g[l], conv_ln_b[l])
        mix = jnp.concatenate([rms_norm(o_nsa, out_norm_nsa_g[l]), rms_norm(o_conv, out_norm_conv_g[l])], axis=-1)
        x = x + mix @ w_out[l]
        hn = rms_norm(x, ffn_norm_g[l])
        g_ff, u_ff = jnp.split(hn @ w_gate_up[l], 2, axis=-1)
        x = x + (jax.nn.silu(g_ff) * u_ff) @ w_down[l]
    return x
```

```cpp
#include <hip/hip_runtime.h>
#include <cstdio>
#include <cstdint>

#ifndef MK_N_LAUNCHES
#define MK_N_LAUNCHES 1
#endif
#ifndef DUP_PHASE
#define DUP_PHASE -1
#endif

typedef _Float16 half_t;
typedef _Float16 h8 __attribute__((ext_vector_type(8)));
typedef _Float16 h4 __attribute__((ext_vector_type(4)));
typedef _Float16 h2 __attribute__((ext_vector_type(2)));
typedef float f32x2 __attribute__((ext_vector_type(2)));
typedef float f32x4 __attribute__((ext_vector_type(4)));
typedef float f32x16 __attribute__((ext_vector_type(16)));
typedef unsigned u32x2 __attribute__((ext_vector_type(2)));
typedef unsigned u32x4 __attribute__((ext_vector_type(4)));
typedef short s16x4 __attribute__((ext_vector_type(4)));

#define LAS __attribute__((address_space(3)))
#define GAS __attribute__((address_space(1)))

constexpr int D_MODEL = 1024, BATCH = 8, SEQ = 2048, M = BATCH * SEQ;
constexpr int HD = 64, NH = 8, NG = 2, NSA_W = 512, CONV_CH = 512;
constexpr int NCMP = 127, NCMP_PAD = 128, CMP_HID = 256;
constexpr int FFN = 2816, IN_W = 2328, IN_PAD = 2560;
constexpr float EPS = 1e-6f;
constexpr float LOG2E = 1.4426950408889634f;

__device__ __forceinline__ unsigned pkh(float lo, float hi) { f32x2 v = {lo, hi}; h2 h = __builtin_convertvector(v, h2); return __builtin_bit_cast(unsigned, h); }
typedef __bf16 b2 __attribute__((ext_vector_type(2)));
typedef __bf16 b8 __attribute__((ext_vector_type(8)));
__device__ __forceinline__ unsigned pkb(float lo, float hi) { f32x2 v = {lo, hi}; b2 h = __builtin_convertvector(v, b2); return __builtin_bit_cast(unsigned, h); }
#ifndef FFN_BF16
#define FFN_BF16 1
#endif
#ifndef IN_BF16
#define IN_BF16 1
#endif
#ifndef MIX_BF16
#define MIX_BF16 1
#endif
#define PKM(lo, hi) (MIX_BF16 ? pkb(lo, hi) : pkh(lo, hi))
#define PKI(lo, hi) (IN_BF16 ? pkb(lo, hi) : pkh(lo, hi))
__device__ __forceinline__ float sigmoidf_(float x) { return __builtin_amdgcn_rcpf(1.0f + __builtin_amdgcn_exp2f(-x * LOG2E)); }
__device__ __forceinline__ float wave_sum(float v) {
#pragma unroll
    for (int o = 1; o < 64; o <<= 1) v += __shfl_xor(v, o);
    return v;
}

namespace pg8 {
constexpr int BM = 256, BK = 64, HALF = 128, HTB = HALF * BK * 2, STAGE_BYTES = 8 * HTB, NXCD = 8, WGM = 8;
__host__ __device__ __forceinline__ int lds_byte(int r, int c) { const int st = (r >> 4) * 2 + (c >> 5), rr = r & 15, cc = c & 31, ob = rr * 64 + cc * 2; return st * 1024 + (ob ^ (((ob >> 9) & 1) << 5)); }
__host__ __device__ __forceinline__ void stage_rc(int b, int& R, int& C) { const int st = b / 1024, sb = b % 1024, swz = sb ^ (((sb >> 9) & 1) << 5); R = (st >> 1) * 16 + swz / 64; C = (st & 1) * 32 + (swz % 64) / 2; }
__host__ __device__ __forceinline__ int perm32(int rho) { const int n = rho >> 4, i = rho & 15; return 8 * (i >> 2) + 4 * n + (i & 3); }

struct Unit { int pm, pn, hh; };
struct Gemm { const half_t* A; const half_t* Bt; int M, N, K, lda, ldb; };

struct StaticOrder {
    int nM, nN, nwg, G, c, maxr;
    __host__ __device__ void init(int M_, int N_, int G_, int c_) { nM = M_ / BM; nN = N_ / BM; nwg = nM * nN; G = G_; c = c_; maxr = 1 << 30; }
    __host__ __device__ bool next(int i, Unit& u) const {
        const long L = (long)i * G + c; if (L >= nwg || i >= maxr) return false; u.hh = 0;
        int wgid = (int)L; { const int q = nwg / NXCD, r = nwg % NXCD, xcd = wgid % NXCD, off = wgid / NXCD; wgid = (xcd < r ? xcd * (q + 1) : r * (q + 1) + (xcd - r) * q) + off; }
        const int nig = WGM * nN, gid = wgid / nig, fm = gid * WGM, gsz = (nM - fm) < WGM ? (nM - fm) : WGM;
        u.pm = fm + ((wgid % nig) % gsz); u.pn = (wgid % nig) / gsz; return true;
    }
};

struct SingleOrder { bool has; __device__ bool next(int i, Unit& u) const { if (i == 0 && has) { u.pm = 0; u.pn = 0; u.hh = 0; return true; } return false; } };
struct TailHalfOrder { StaticOrder S; int r;
    __device__ bool next(int i, Unit& u) const { if (i != 0) return false; StaticOrder T = S; const int half = S.G / 2; T.c = S.c % half; if (!T.next(r, u)) return false; u.hh = S.c / half; return true; } };
template <class Epi, class Sched, bool ALIGN_EPI, bool BF = false, bool HALFM = false>
__device__ __forceinline__ void gemm_phase(LAS unsigned char* lds, const Gemm g, const Sched& S, const Epi& E) {
    const int tid = threadIdx.x, wid = __builtin_amdgcn_readfirstlane(tid >> 6), lane = tid & 63, wr = wid >> 2, wc = wid & 3, fr = lane & 15, fq = lane >> 4;
    const int K = g.K, nt = K / BK;
    unsigned voffA[2], voffB[2];
#pragma unroll
    for (int i = 0; i < 2; ++i) { int R, C; stage_rc(tid * 16 + i * 8192, R, C); const int Rb = Epi::PERM ? ((R & ~31) + perm32(R & 31)) : R;
        voffA[i] = (unsigned)(R * g.lda + C) * 2u; voffB[i] = (unsigned)(Rb * g.ldb + C) * 2u; }
    const size_t kstep = (size_t)(BK * 2);
    const size_t hstepA = (size_t)HALF * g.lda * 2, hstepB = (size_t)HALF * g.ldb * 2;
    const size_t tstepA = 2 * hstepA, tstepB = 2 * hstepB;
    const unsigned ldsw = (unsigned)wid * 1024u;
    const int aoff = lds_byte(wr * 64 + fr, fq * 8), boff = lds_byte(wc * 32 + fr, fq * 8);
#define PG8_SA(b, h) (((b) * 2 + (h)) * HTB)
#define PG8_SB(b, h) ((4 + (b) * 2 + (h)) * HTB)
#define PG8_STAGE(bufoff, gbase, voff) do { _Pragma("unroll") for (int _i = 0; _i < 2; ++_i) \
        __builtin_amdgcn_global_load_lds((const unsigned*)((const char*)(gbase) + (voff)[_i]), (LAS unsigned*)(lds + (bufoff) + ldsw + _i * 8192), 16, 0, 0); } while (0)
#define PG8_LDA(dst, b, h) do { _Pragma("unroll") for (int m = 0; m < 4; ++m) _Pragma("unroll") for (int k = 0; k < 2; ++k) dst[m][k] = *(const LAS h8*)(lds + PG8_SA(b, h) + aoff + m * 2048 + k * 1024); } while (0)
#define PG8_LDB(dst, b, h) do { _Pragma("unroll") for (int n = 0; n < 2; ++n) _Pragma("unroll") for (int k = 0; k < 2; ++k) dst[n][k] = *(const LAS h8*)(lds + PG8_SB(b, h) + boff + n * 2048 + k * 1024); } while (0)
#define PG8_MMA(ai, bj, At, Bt) do { __builtin_amdgcn_s_setprio(1); _Pragma("unroll") for (int m = 0; m < 4; ++m) _Pragma("unroll") for (int n = 0; n < 2; ++n) _Pragma("unroll") for (int k = 0; k < 2; ++k) \
        acc[ai][bj][m][n] = BF ? __builtin_amdgcn_mfma_f32_16x16x32_bf16(__builtin_bit_cast(b8, Bt[n][k]), __builtin_bit_cast(b8, At[m][k]), acc[ai][bj][m][n], 0, 0, 0) \
                               : __builtin_amdgcn_mfma_f32_16x16x32_f16(Bt[n][k], At[m][k], acc[ai][bj][m][n], 0, 0, 0); __builtin_amdgcn_s_setprio(0); } while (0)
#define PG8_WAIT_V(n) asm volatile("s_waitcnt vmcnt(" #n ")" ::: "memory")
#define PG8_WAIT_L(n) asm volatile("s_waitcnt lgkmcnt(" #n ")" ::: "memory")
#define PG8_BAR __builtin_amdgcn_s_barrier()
#define PG8_SCHED __builtin_amdgcn_sched_barrier(0)
    Unit cur, nxt; int ui = 0;
    if (!S.next(0, cur)) return;
    f32x4 acc[2][2][4][2];
#pragma unroll
    for (int a = 0; a < 2; ++a)
#pragma unroll
        for (int b = 0; b < 2; ++b)
#pragma unroll
            for (int m = 0; m < 4; ++m)
#pragma unroll
                for (int n = 0; n < 2; ++n) acc[a][b][m][n] = (f32x4){0.f, 0.f, 0.f, 0.f};
    h8 At[4][2], B0[2][2], B1[2][2];
    const char* cA = (const char*)g.A + (size_t)cur.pm * tstepA + (HALFM ? (size_t)cur.hh * hstepA : 0); const char* cB = (const char*)g.Bt + (size_t)cur.pn * tstepB;
#define PG8_STAGE_A1(bufoff, gbase, voff) do { if (!HALFM) PG8_STAGE(bufoff, gbase, voff); } while (0)
#define PG8_WAIT_VH(n_full, n_half) do { if (HALFM) PG8_WAIT_V(n_half); else PG8_WAIT_V(n_full); } while (0)
    PG8_STAGE(PG8_SB(0, 0), cB, voffB); PG8_STAGE(PG8_SB(0, 1), cB + hstepB, voffB); PG8_STAGE(PG8_SA(0, 0), cA, voffA); PG8_STAGE_A1(PG8_SA(0, 1), cA + hstepA, voffA);
    if (wr == 1) PG8_BAR;
    PG8_WAIT_VH(2, 0); PG8_BAR;
    PG8_STAGE(PG8_SB(1, 0), cB + kstep, voffB); PG8_STAGE(PG8_SA(1, 0), cA + kstep, voffA); PG8_STAGE(PG8_SB(1, 1), cB + hstepB + kstep, voffB);
    PG8_WAIT_V(6); PG8_BAR;
    for (;;) {
        const bool has_next = S.next(ui + 1, nxt);
        const char* nA = has_next ? (const char*)g.A + (size_t)nxt.pm * tstepA + (HALFM ? (size_t)nxt.hh * hstepA : 0) : cA; const char* nB = has_next ? (const char*)g.Bt + (size_t)nxt.pn * tstepB : cB;
        for (int t = 0; t < nt; t += 2) {
            const bool last = (t == nt - 2);
            const char* a1 = cA + (size_t)(t + 1) * kstep;
            const char* a2 = last ? nA : cA + (size_t)(t + 2) * kstep; const char* b2 = last ? nB : cB + (size_t)(t + 2) * kstep;
            const char* a3 = a2 + kstep; const char* b3 = b2 + kstep;
            PG8_LDB(B0, 0, 0); PG8_LDB(B1, 0, 1); PG8_SCHED; PG8_LDA(At, 0, 0); PG8_STAGE_A1(PG8_SA(1, 1), a1 + hstepA, voffA);
            PG8_WAIT_VH(8, 6); PG8_WAIT_L(0); PG8_BAR; PG8_MMA(0, 0, At, B0); PG8_MMA(0, 1, At, B1); PG8_BAR; PG8_SCHED;
            if (!HALFM) PG8_LDA(At, 0, 1); PG8_STAGE(PG8_SB(0, 0), b2, voffB); PG8_STAGE(PG8_SB(0, 1), b2 + hstepB, voffB); PG8_STAGE(PG8_SA(0, 0), a2, voffA);
            PG8_WAIT_VH(8, 6); PG8_WAIT_L(0); PG8_BAR; if (!HALFM) { PG8_MMA(1, 0, At, B0); PG8_MMA(1, 1, At, B1); } PG8_BAR; PG8_SCHED;
            PG8_LDB(B0, 1, 0); PG8_LDB(B1, 1, 1); PG8_SCHED; PG8_LDA(At, 1, 0); PG8_STAGE_A1(PG8_SA(0, 1), a2 + hstepA, voffA);
            PG8_WAIT_VH(8, 6); PG8_WAIT_L(0); PG8_BAR; PG8_MMA(0, 0, At, B0); PG8_MMA(0, 1, At, B1); PG8_BAR; PG8_SCHED;
            if (!HALFM) PG8_LDA(At, 1, 1); PG8_STAGE(PG8_SB(1, 0), b3, voffB); PG8_STAGE(PG8_SB(1, 1), b3 + hstepB, voffB); PG8_STAGE(PG8_SA(1, 0), a3, voffA);
            PG8_WAIT_VH(8, 6); PG8_WAIT_L(0); PG8_BAR; if (!HALFM) { PG8_MMA(1, 0, At, B0); PG8_MMA(1, 1, At, B1); } PG8_BAR; PG8_SCHED;
        }
        if constexpr (ALIGN_EPI) { if (wr == 0) PG8_BAR; }
        if constexpr (!Epi::AFTER_DRAIN) { E(acc, cur, wr, wc, fr, fq); }
        if (!has_next) break;
#pragma unroll
        for (int a = 0; a < 2; ++a)
#pragma unroll
            for (int b = 0; b < 2; ++b)
#pragma unroll
                for (int m = 0; m < 4; ++m)
#pragma unroll
                    for (int n = 0; n < 2; ++n) acc[a][b][m][n] = (f32x4){0.f, 0.f, 0.f, 0.f};
        cur = nxt; cA = nA; cB = nB; ++ui;
        if constexpr (ALIGN_EPI) { if (wr == 1) PG8_BAR; }
    }
    PG8_WAIT_V(0);
    if constexpr (!ALIGN_EPI) { if (wr == 0) PG8_BAR; }
    PG8_BAR;
    if constexpr (Epi::AFTER_DRAIN) { E.fused(acc, cur, wr, wc, fr, fq, lds, wid, lane); }
#undef PG8_SA
#undef PG8_SB
#undef PG8_STAGE
#undef PG8_STAGE_A1
#undef PG8_WAIT_VH
#undef PG8_LDA
#undef PG8_LDB
#undef PG8_MMA
#undef PG8_WAIT_V
#undef PG8_WAIT_L
#undef PG8_BAR
#undef PG8_SCHED
}

struct EpiInProj {
    static constexpr bool PERM = true, AFTER_DRAIN = false;
    unsigned char* ws;
    __device__ __forceinline__ void operator()(const f32x4 (&acc)[2][2][4][2], const Unit& u, int wr, int wc, int fr, int fq) const {
        const int pn = u.pn, c8 = wc * 32 + 8 * fq;
#pragma unroll
        for (int ai = 0; ai < 2; ++ai)
#pragma unroll
            for (int m = 0; m < 4; ++m) {
                const int row = u.pm * BM + ai * HALF + wr * 64 + m * 16 + fr;
                if (pn < 5) {
                    size_t off0, bjstep;
                    if (pn < 2) { off0 = 134217728ull   + ((size_t)row * NSA_W + pn * 256 + c8) * 2; bjstep = HALF * 2; }
                    else { const int b = row >> 11, t = row & 2047, gg = c8 >> 6, d = c8 & 63;
                        off0 = 167772160ull   + (size_t)((pn - 2) * 2) * 5242880ull + (((size_t)((b * 2 + gg) * SEQ + t)) * HD + d) * 2; bjstep = 5242880ull; }
#pragma unroll
                    for (int bj = 0; bj < 2; ++bj) { const f32x4 v0 = acc[ai][bj][m][0], v1 = acc[ai][bj][m][1];
                        u32x4 w; w.x = pkh(v0[0], v0[1]); w.y = pkh(v0[2], v0[3]); w.z = pkh(v1[0], v1[1]); w.w = pkh(v1[2], v1[3]);
                        *(u32x4*)(ws + off0 + bj * bjstep) = w; }
                } else if (pn < 9) {
                    float o[8];
#pragma unroll
                    for (int n = 0; n < 2; ++n)
#pragma unroll
                        for (int j = 0; j < 4; ++j) o[n * 4 + j] = acc[ai][0][m][n][j] * sigmoidf_(acc[ai][1][m][n][j]);
                    u32x4 w; w.x = pkh(o[0], o[1]); w.y = pkh(o[2], o[3]); w.z = pkh(o[4], o[5]); w.w = pkh(o[6], o[7]);
                    *(u32x4*)(ws + 150994944ull   + ((size_t)row * CONV_CH + (pn - 5) * HALF + c8) * 2) = w;
                } else {
                    if (wc == 0 && fq < 3) {
#pragma unroll
                        for (int n = 0; n < 2; ++n) { f32x4 v = acc[ai][0][m][n]; f32x4 s; s[0] = sigmoidf_(v[0]); s[1] = sigmoidf_(v[1]); s[2] = sigmoidf_(v[2]); s[3] = sigmoidf_(v[3]);
                            *(f32x4*)(ws + 31457280ull   + ((size_t)row * 24 + 8 * fq + 4 * n) * 4) = s; }
                    }
                }
            }
    }
};
struct EpiF32 {
    static constexpr bool PERM = false, AFTER_DRAIN = false;
    float* C; int ldc;
    __device__ __forceinline__ void operator()(const f32x4 (&acc)[2][2][4][2], const Unit& u, int wr, int wc, int fr, int fq) const {
        const int row0 = u.pm * BM + wr * 64 + fr, col0 = u.pn * BM + wc * 32 + 4 * fq;
#pragma unroll
        for (int ai = 0; ai < 2; ++ai)
#pragma unroll
            for (int m = 0; m < 4; ++m) { float* rowp = C + (size_t)(row0 + ai * HALF + m * 16) * ldc + col0;
#pragma unroll
                for (int bj = 0; bj < 2; ++bj)
#pragma unroll
                    for (int n = 0; n < 2; ++n) *(f32x4*)(rowp + bj * HALF + n * 16) = acc[ai][bj][m][n]; }
    }
};
struct EpiOutProj {
    static constexpr bool PERM = false, AFTER_DRAIN = true;
    const float* x; half_t* H1H; float* SSQ;
    __device__ __forceinline__ void fused(f32x4 (&acc)[2][2][4][2], const Unit& u, int wr, int wc, int fr, int fq, LAS unsigned char* lds, int wid, int lane) const {
        LAS float* P = (LAS float*)lds;
        const int col0 = u.pn * BM + wc * 32 + 4 * fq;
#pragma unroll
        for (int ai = 0; ai < 2; ++ai)
#pragma unroll
            for (int m = 0; m < 4; ++m) {
                const int rl = ai * HALF + wr * 64 + m * 16 + fr; const size_t off = (size_t)(u.pm * BM + rl) * D_MODEL + col0; float ss = 0.f;
#pragma unroll
                for (int bj = 0; bj < 2; ++bj)
#pragma unroll
                    for (int n = 0; n < 2; ++n) { const f32x4 xv = *(const f32x4*)(x + off + bj * HALF + n * 16); const f32x4 h = xv + acc[ai][bj][m][n];
                        u32x2 w; if (FFN_BF16) { w.x = pkb(h[0], h[1]); w.y = pkb(h[2], h[3]); } else { w.x = pkh(h[0], h[1]); w.y = pkh(h[2], h[3]); } *(u32x2*)(H1H + off + bj * HALF + n * 16) = w;
                        ss += (h[0] * h[0] + h[1] * h[1]) + (h[2] * h[2] + h[3] * h[3]); }
                ss += __shfl_xor(ss, 16); ss += __shfl_xor(ss, 32);
                if (fq == 0) P[rl * 4 + wc] = ss;
            }
        asm volatile("s_waitcnt lgkmcnt(0)" ::: "memory"); __builtin_amdgcn_s_barrier(); asm volatile("" ::: "memory");
        const int tid = wid * 64 + lane;
        if (tid < 256) { const float s = (P[tid * 4 + 0] + P[tid * 4 + 1]) + (P[tid * 4 + 2] + P[tid * 4 + 3]); SSQ[(size_t)(u.pm * BM + tid) * 4 + u.pn] = s; }
        asm volatile("s_waitcnt lgkmcnt(0)" ::: "memory"); __builtin_amdgcn_s_barrier(); asm volatile("" ::: "memory");
    }
};
struct EpiGateUp {
    static constexpr bool PERM = true, AFTER_DRAIN = false;
    const LAS float* RT; unsigned char* ws; bool half;
    __device__ __forceinline__ void operator()(const f32x4 (&acc)[2][2][4][2], const Unit& u, int wr, int wc, int fr, int fq) const {
        const int c8 = wc * 32 + 8 * fq;
        const __amdgpu_buffer_rsrc_t rs = __builtin_amdgcn_make_buffer_rsrc(ws, 0, 0x10000000, 0x00020000);
#pragma unroll
        for (int ai = 0; ai < 2; ++ai)
#pragma unroll
            for (int m = 0; m < 4; ++m) {
                if (half && ai == 1) continue;
                const int rl = (half ? u.hh : ai) * HALF + wr * 64 + m * 16 + fr, row = u.pm * BM + rl;
                const float r = RT[(u.pm & 7) * BM + rl];
                float o[8];
#pragma unroll
                for (int n = 0; n < 2; ++n)
#pragma unroll
                    for (int j = 0; j < 4; ++j) { const float gv = acc[ai][0][m][n][j] * r, uv = acc[ai][1][m][n][j] * r; o[n * 4 + j] = gv * sigmoidf_(gv) * uv; }
                u32x4 w; if (FFN_BF16) { w.x = pkb(o[0], o[1]); w.y = pkb(o[2], o[3]); w.z = pkb(o[4], o[5]); w.w = pkb(o[6], o[7]); } else { w.x = pkh(o[0], o[1]); w.y = pkh(o[2], o[3]); w.z = pkh(o[4], o[5]); w.w = pkh(o[6], o[7]); }
                __builtin_amdgcn_raw_buffer_store_b128(w, rs, (unsigned)(100663296u + ((unsigned)row * FFN + u.pn * HALF + c8) * 2u), 0, 16);
            }
    }
};
struct EpiDown {
    static constexpr bool PERM = false, AFTER_DRAIN = false;
    const half_t* H1H; float* out;
    __device__ __forceinline__ void operator()(const f32x4 (&acc)[2][2][4][2], const Unit& u, int wr, int wc, int fr, int fq) const {
        const int row0 = u.pm * BM + wr * 64 + fr, col0 = u.pn * BM + wc * 32 + 4 * fq;
#pragma unroll
        for (int ai = 0; ai < 2; ++ai)
#pragma unroll
            for (int m = 0; m < 4; ++m) { const size_t off = (size_t)(row0 + ai * HALF + m * 16) * D_MODEL + col0;
#pragma unroll
                for (int bj = 0; bj < 2; ++bj)
#pragma unroll
                    for (int n = 0; n < 2; ++n) { const u32x2 hh = *(const u32x2*)(H1H + off + bj * HALF + n * 16); f32x4 h;
                        if (FFN_BF16) { h[0] = __uint_as_float(hh.x << 16); h[1] = __uint_as_float(hh.x & 0xffff0000u); h[2] = __uint_as_float(hh.y << 16); h[3] = __uint_as_float(hh.y & 0xffff0000u); }
                        else { const h4 q = __builtin_bit_cast(h4, hh); h[0] = (float)q[0]; h[1] = (float)q[1]; h[2] = (float)q[2]; h[3] = (float)q[3]; }
                        *(f32x4*)(out + off + bj * HALF + n * 16) = h + acc[ai][bj][m][n]; } }
    }
};
}

constexpr int NWAVES = 8;
constexpr int N_PHASES = 8;
constexpr size_t MiB = 1u << 20;
constexpr size_t WS_CTL = 0, CTL_ZERO_BYTES = 128 * 1024;
constexpr size_t WS_BIASP = 1 * MiB;
constexpr size_t WS_ROPEC = 1 * MiB + 64 * 1024;
constexpr size_t WS_ROPES = WS_ROPEC + 256 * 1024;
constexpr size_t WS_SSQ = WS_ROPES + 256 * 1024;
constexpr size_t WS_GMAX = 1 * MiB + 32 * 1024;
constexpr size_t WS_W1K = 3 * MiB, WS_W1V = 4 * MiB;
constexpr size_t WS_WIN = 5 * MiB;
constexpr size_t WS_WOUT = 10 * MiB;
constexpr size_t WS_WGU = 12 * MiB;
constexpr size_t WS_WDN = 23 * MiB;
constexpr size_t WS_KCMP = 29 * MiB, WS_VCMP = 29 * MiB + 256 * 1024;
constexpr size_t WS_GATES = 30 * MiB;
constexpr size_t WS_H1H = 32 * MiB;
constexpr size_t WS_MIX = 64 * MiB;
constexpr size_t WS_HB = 96 * MiB;
constexpr size_t WS_XN = 96 * MiB;
constexpr size_t WS_Q = 128 * MiB;
constexpr size_t WS_HCV = 144 * MiB;
constexpr size_t WS_KV6 = 160 * MiB, KV6_STRIDE = 5 * MiB;
constexpr size_t WS_KC = WS_KV6, WS_VC = WS_KV6 + KV6_STRIDE, WS_KSR = WS_KV6 + 2 * KV6_STRIDE, WS_VS = WS_KV6 + 3 * KV6_STRIDE, WS_KWR = WS_KV6 + 4 * KV6_STRIDE, WS_VW = WS_KV6 + 5 * KV6_STRIDE;
constexpr size_t WS_HIDP = 96 * MiB;
constexpr size_t WS_KS = 200 * MiB, WS_KW = 204 * MiB;
constexpr size_t WS_END = 208 * MiB;
static_assert(WS_HB == 100663296ull, "EpiGateUp literal offset");
static_assert(WS_Q == 134217728ull && WS_KV6 == 167772160ull && KV6_STRIDE == 5242880ull && WS_HCV == 150994944ull && WS_GATES == 31457280ull, "EpiInProj literal offsets");
constexpr int CW_BAR = 1024;

constexpr int RING_BYTES = 131072;
constexpr int LDSCTL_OFF = 147456, MISC_OFF = LDSCTL_OFF + 320;
constexpr int LDS_BYTES = 147456 + 1024;

typedef GAS unsigned gu32;
#define RLX_AGENT __ATOMIC_RELAXED, __HIP_MEMORY_SCOPE_AGENT

#define XB_TMO      128
#define XB_XCNT(j)  (256  + 64 * (j))
#define XB_XSUB(j)  (1280 + 64 * (j))
#define XB_XGEN(j)  (2304 + 64 * (j))
#define XB_TOP      3328
#define XB_TOPGEN   3392
#define XCD_BAR_WORDS 3456
#define XB_SPIN_CAP (1u << 22)
__device__ __forceinline__ unsigned xb_ld(unsigned* p)              { return __hip_atomic_load(p, __ATOMIC_RELAXED, __HIP_MEMORY_SCOPE_AGENT); }
__device__ __forceinline__ unsigned xb_add(unsigned* p, unsigned v) { return __hip_atomic_fetch_add(p, v, __ATOMIC_RELAXED, __HIP_MEMORY_SCOPE_AGENT); }
__device__ __forceinline__ unsigned xb_xcc_id() { return (unsigned)__builtin_amdgcn_s_getreg((3 << 11) | 20) & 0xFu; }
#define XB_SPIN(cond, bar) do { unsigned _sp = 0; while (cond) { __builtin_amdgcn_s_sleep(1); \
    if ((++_sp & 255u) == 0u) { if (xb_ld(&(bar)[XB_TMO])) break; if (_sp > XB_SPIN_CAP) { atomicAdd(&(bar)[XB_TMO], 1u); break; } } } } while (0)
struct XcdBarrier { unsigned* bar; unsigned x; volatile LAS unsigned* st; };
__device__ __forceinline__ XcdBarrier xcd_barrier_post(unsigned* bar, volatile LAS unsigned* st) {
    XcdBarrier b; b.bar = bar; b.x = xb_xcc_id(); b.st = st;
    if (threadIdx.x == 0) (void)xb_add(&bar[XB_XCNT(b.x)], 1u);
    return b;
}
__device__ __forceinline__ void xcd_barrier_complete(unsigned* bar, unsigned x, unsigned& nloc, unsigned& nx) {
    const unsigned G = gridDim.x * gridDim.y * gridDim.z;
    unsigned sum, cnt, mine, sp = 0u;
    for (;;) {
        sum = 0u; cnt = 0u; mine = 0u;
#pragma unroll
        for (unsigned j = 0; j < 16; ++j) { const unsigned c = xb_ld(&bar[XB_XCNT(j)]); sum += c; cnt += (c > 0u) ? 1u : 0u; mine = (j == x) ? c : mine; }
        if (sum == G) break;
        __builtin_amdgcn_s_sleep(1);
        if ((++sp & 255u) == 0u) { if (xb_ld(&bar[XB_TMO])) break; if (sp > XB_SPIN_CAP) { atomicAdd(&bar[XB_TMO], 1u); break; } }
    }
    nloc = mine > 0u ? mine : 1u; nx = cnt > 0u ? cnt : 1u;
}
__device__ __forceinline__ void xcd_barrier(const XcdBarrier& b) {
    asm volatile("s_waitcnt vmcnt(0)" ::: "memory");
    __syncthreads();
    if (threadIdx.x == 0) {
        unsigned* bar = b.bar;
        __builtin_amdgcn_s_waitcnt(0);
        unsigned nloc = b.st[0], nx = b.st[1];
        if (nloc == 0u) { xcd_barrier_complete(bar, b.x, nloc, nx); b.st[0] = nloc; b.st[1] = nx; }
        const unsigned old = xb_add(&bar[XB_XSUB(b.x)], 1u);
        const unsigned gen = old / nloc;
        if (old + 1u == (gen + 1u) * nloc) {
            __builtin_amdgcn_fence(__ATOMIC_RELEASE, "agent");
            asm volatile("s_waitcnt vmcnt(0)" ::: "memory");
            const unsigned og = xb_add(&bar[XB_TOP], 1u);
            const unsigned tg = og / nx;
            if (og + 1u == (tg + 1u) * nx) xb_add(&bar[XB_TOPGEN], 1u);
            else XB_SPIN(xb_ld(&bar[XB_TOPGEN]) == tg, bar);
            __builtin_amdgcn_fence(__ATOMIC_ACQUIRE, "agent");
            xb_add(&bar[XB_XGEN(b.x)], 1u);
            asm volatile("s_waitcnt vmcnt(0)" ::: "memory");
        } else {
            XB_SPIN(xb_ld(&bar[XB_XGEN(b.x)]) == gen, bar);
            __builtin_amdgcn_fence(__ATOMIC_ACQUIRE, "agent");
            asm volatile("s_waitcnt vmcnt(0)" ::: "memory");
        }
    }
    __syncthreads();
}

struct Args { const float* in[23]; float* out; unsigned char* ws; int ph_lo, ph_hi, li, pad; };

struct Frame {
    LAS unsigned char* lds;
    int tid, lane, wave, vcu, G;
    unsigned char* ws;
};

__device__ __forceinline__ int map_col(int mode, int n) {
    if (mode == 0) return n;
    if (mode == 1) {
        if (n < 1280) return n;
        if (n < 1304) return 2304 + (n - 1280);
        if (n < 1816) { const int c = n - 1304; return 1280 + (c >> 7) * 256 + (c & 127); }
        const int c = n - 1816; return 1280 + (c >> 7) * 256 + 128 + (c & 127);
    }
    if (n < FFN) return (n >> 7) * 256 + (n & 127);
    const int c = n - FFN; return (c >> 7) * 256 + 128 + (c & 127);
}
constexpr int TR_SCR = 64 * 65 * 4;
template <bool BF = false>
__device__ __forceinline__ void p0_transpose_item(const float* W, int K, int N, half_t* WT, int mode, const float* sc, LAS float* scr, int item, int lane) {
    const int nblk = (N + 63) / 64, kb = item / nblk, nb = item % nblk, k0 = 64 * kb, n0 = 64 * nb;
    const int nn = n0 + (lane & 15) * 4; const bool nok = nn < N;
    f32x4 v[16];
#pragma unroll
    for (int i = 0; i < 16; ++i) { const int kk = 4 * i + (lane >> 4); v[i] = nok ? *(const f32x4*)(W + (size_t)(k0 + kk) * N + nn) : (f32x4){0.f, 0.f, 0.f, 0.f}; if (sc) v[i] *= sc[k0 + kk]; }
#pragma unroll
    for (int i = 0; i < 16; ++i) { const int kk = 4 * i + (lane >> 4); LAS float* d = scr + kk * 65 + (lane & 15) * 4; d[0] = v[i][0]; d[1] = v[i][1]; d[2] = v[i][2]; d[3] = v[i][3]; }
    asm volatile("s_waitcnt lgkmcnt(0)" ::: "memory");
    const int c = lane & 7;
#pragma unroll
    for (int j = 0; j < 8; ++j) { const int n = (lane >> 3) + 8 * j; const LAS float* s = scr + (8 * c) * 65 + n;
        u32x4 o; if (BF) { o.x = pkb(s[0 * 65], s[1 * 65]); o.y = pkb(s[2 * 65], s[3 * 65]); o.z = pkb(s[4 * 65], s[5 * 65]); o.w = pkb(s[6 * 65], s[7 * 65]); }
        else { o.x = pkh(s[0 * 65], s[1 * 65]); o.y = pkh(s[2 * 65], s[3 * 65]); o.z = pkh(s[4 * 65], s[5 * 65]); o.w = pkh(s[6 * 65], s[7 * 65]); }
        if (n0 + n < N) *(u32x4*)(WT + (size_t)map_col(mode, n0 + n) * K + k0 + 8 * c) = o; }
    asm volatile("s_waitcnt lgkmcnt(0)" ::: "memory");
}
__device__ __forceinline__ void p0_prologue(Frame& F, const Args& a) {
    LAS float* scr = (LAS float*)(F.lds + F.wave * TR_SCR);
    const int gw = F.vcu * NWAVES + F.wave, NGW = F.G * NWAVES, lane = F.lane;
    const float* w_in = a.in[2]; const float* w1k = a.in[8]; const float* w1v = a.in[11];
    constexpr int I_IN = 16 * 37, I_W1 = 32 * 4;
    constexpr int NITEMS = I_IN + 2 * I_W1;
    for (int it = gw; it < NITEMS; it += NGW) {
        int r = it;
        if (r < I_IN) { p0_transpose_item<IN_BF16 != 0>(w_in, 1024, IN_W, (half_t*)(F.ws + WS_WIN), 1, nullptr, scr, r, lane); continue; } r -= I_IN;
        if (r < I_W1) { p0_transpose_item(w1k, 2048, 256, (half_t*)(F.ws + WS_W1K), 0, nullptr, scr, r, lane); continue; } r -= I_W1;
        p0_transpose_item(w1v, 2048, 256, (half_t*)(F.ws + WS_W1V), 0, nullptr, scr, r, lane);
    }
    {
        const float* x = a.in[0]; const float* g = a.in[1]; half_t* XN = (half_t*)(F.ws + WS_XN);
        f32x4 gv[4];
#pragma unroll
        for (int j = 0; j < 4; ++j) gv[j] = *(const f32x4*)(g + 4 * lane + 256 * j);
        for (int m = gw; m < M; m += 2 * NGW) {
            const int m2 = m + NGW;
            const f32x4* xr = (const f32x4*)(x + (size_t)m * D_MODEL) + lane; const f32x4* xr2 = (const f32x4*)(x + (size_t)m2 * D_MODEL) + lane; f32x4 v[4], w[4]; float s = 0.f, s2 = 0.f;
#pragma unroll
            for (int j = 0; j < 4; ++j) { v[j] = xr[64 * j]; w[j] = xr2[64 * j]; }
#pragma unroll
            for (int j = 0; j < 4; ++j) { s += (v[j][0] * v[j][0] + v[j][1] * v[j][1]) + (v[j][2] * v[j][2] + v[j][3] * v[j][3]); s2 += (w[j][0] * w[j][0] + w[j][1] * w[j][1]) + (w[j][2] * w[j][2] + w[j][3] * w[j][3]); }
            const float r = 1.0f / sqrtf(wave_sum(s) * (1.0f / D_MODEL) + EPS), r2 = 1.0f / sqrtf(wave_sum(s2) * (1.0f / D_MODEL) + EPS);
            u32x2* o8 = (u32x2*)(XN + (size_t)m * D_MODEL) + lane; u32x2* o82 = (u32x2*)(XN + (size_t)m2 * D_MODEL) + lane;
#pragma unroll
            for (int j = 0; j < 4; ++j) { u32x2 t; t.x = PKI(v[j][0] * r * gv[j][0], v[j][1] * r * gv[j][1]); t.y = PKI(v[j][2] * r * gv[j][2], v[j][3] * r * gv[j][3]); o8[64 * j] = t;
                u32x2 t2; t2.x = PKI(w[j][0] * r2 * gv[j][0], w[j][1] * r2 * gv[j][1]); t2.y = PKI(w[j][2] * r2 * gv[j][2], w[j][3] * r2 * gv[j][3]); o82[64 * j] = t2; }
        }
    }
    {
        float* RC = (float*)(F.ws + WS_ROPEC); float* RS = (float*)(F.ws + WS_ROPES);
        for (int e = gw * 64 + lane; e < SEQ * 32; e += NGW * 64) { const int pos = e >> 5, i = e & 31;
            const float inv = exp2f(-(float)i * (13.287712379549449f / 32.0f)); const float ang = (float)pos * inv; float sn, cs; sincosf(ang, &sn, &cs); RC[e] = cs; RS[e] = sn; }
    }
    if (gw == 0) { float gs = fabsf(a.in[5][lane]), gw_ = fabsf(a.in[6][lane]);
#pragma unroll
        for (int o = 1; o < 64; o <<= 1) { gs = fmaxf(gs, __shfl_xor(gs, o)); gw_ = fmaxf(gw_, __shfl_xor(gw_, o)); }
        if (lane == 0) { float* GM = (float*)(F.ws + WS_GMAX); GM[0] = gs; GM[1] = gw_; } }
    {
        float* BP = (float*)(F.ws + WS_BIASP);
        for (int it = gw; it < 16 * 2 * 4; it += NGW) { const int seg = it >> 3, kv = (it >> 2) & 1, jb = it & 3, j = jb * 64 + lane;
            const float* pe = kv ? a.in[10] : a.in[7]; const float* w1 = kv ? a.in[11] : a.in[8]; float s = 0.f;
            for (int r = seg * 128; r < seg * 128 + 128; ++r) s += pe[r] * w1[(size_t)r * CMP_HID + j];
            BP[(seg * 2 + kv) * CMP_HID + j] = s; }
    }
}

__device__ __forceinline__ void late_weights(Frame& F, const Args& a, int wi, int nw) {
    LAS float* scr = (LAS float*)(F.lds + F.wave * TR_SCR);
    const float* w_out = a.in[19]; const float* w_gu = a.in[21]; const float* w_dn = a.in[22];
    constexpr int I_OUT = 16 * 16, I_GU = 16 * 88, I_DN = 44 * 16;
    for (int it = wi; it < I_OUT + I_GU + I_DN; it += nw) {
        int r = it;
        if (r < I_OUT) { p0_transpose_item<MIX_BF16 != 0>(w_out, 1024, 1024, (half_t*)(F.ws + WS_WOUT), 0, nullptr, scr, r, F.lane); continue; } r -= I_OUT;
        if (r < I_GU) { p0_transpose_item<FFN_BF16 != 0>(w_gu, 1024, 2 * FFN, (half_t*)(F.ws + WS_WGU), 2, a.in[20], scr, r, F.lane); continue; } r -= I_GU;
        p0_transpose_item<FFN_BF16 != 0>(w_dn, FFN, 1024, (half_t*)(F.ws + WS_WDN), 0, nullptr, scr, r, F.lane);
    }
}
__device__ __forceinline__ void conv_item(Frame& F, const Args& a, int item) {
    const int c = F.tid, r0 = item * 64, b = r0 >> 11, tl0 = r0 & 2047, lane = F.lane;
    const half_t* HCV = (const half_t*)(F.ws + WS_HCV); half_t* MIX = (half_t*)(F.ws + WS_MIX);
    const float* cw = a.in[13];
    LAS half_t* X = (LAS half_t*)F.lds;
    LAS float* Y = (LAS float*)(F.lds + 65536);
    float w[31];
#pragma unroll
    for (int k = 0; k < 31; ++k) w[k] = cw[k * CONV_CH + c];
    const float bias = a.in[14][c];
    const float* lg = a.in[15]; const float* lb = a.in[16]; const float* og = a.in[18];
    float g8[8], b8[8], o8[8];
#pragma unroll
    for (int i = 0; i < 8; ++i) { g8[i] = lg[lane * 8 + i]; b8[i] = lb[lane * 8 + i]; o8[i] = og[lane * 8 + i]; }
#pragma unroll 1
    for (int jh = 0; jh < 2; ++jh) {
        u32x4 st[8];
#pragma unroll
        for (int k = 0; k < 8; ++k) { const int id = c + 512 * k, rr = id >> 6, cc = id & 63, tl = tl0 - 30 + 32 * jh + rr;
            st[k] = (rr < 62 && tl >= 0) ? *(const u32x4*)(HCV + (size_t)(b * SEQ + tl) * CONV_CH + cc * 8) : (u32x4){0u, 0u, 0u, 0u}; }
#pragma unroll
        for (int k = 0; k < 8; ++k) { const int id = c + 512 * k; if ((id >> 6) < 62) *(LAS u32x4*)(X + id * 8) = st[k]; }
        __syncthreads();
        float x[62];
#pragma unroll
        for (int i = 0; i < 62; ++i) x[i] = (float)X[i * CONV_CH + c];
#pragma unroll
        for (int j = 0; j < 32; ++j) { float y = bias;
#pragma unroll
            for (int k = 0; k < 31; ++k) y = __builtin_fmaf(w[k], x[j + k], y);
            Y[j * CONV_CH + c] = y; }
        __syncthreads();
#pragma unroll 1
        for (int jj = 0; jj < 4; ++jj) { const int j = F.wave * 4 + jj; float v[8];
            const f32x4 va = *(const LAS f32x4*)(Y + j * CONV_CH + lane * 8), vb = *(const LAS f32x4*)(Y + j * CONV_CH + lane * 8 + 4);
            v[0] = va[0]; v[1] = va[1]; v[2] = va[2]; v[3] = va[3]; v[4] = vb[0]; v[5] = vb[1]; v[6] = vb[2]; v[7] = vb[3];
            float s = 0.f;
#pragma unroll
            for (int i = 0; i < 8; ++i) s += v[i];
            const float mean = wave_sum(s) * (1.0f / CONV_CH); float q = 0.f;
#pragma unroll
            for (int i = 0; i < 8; ++i) { v[i] -= mean; q += v[i] * v[i]; }
            const float rstd = 1.0f / sqrtf(wave_sum(q) * (1.0f / CONV_CH) + EPS); float ss = 0.f;
#pragma unroll
            for (int i = 0; i < 8; ++i) { const float hn = v[i] * rstd * g8[i] + b8[i]; const float sl = hn * sigmoidf_(hn); v[i] = sl; ss += sl * sl; }
            const float r2 = 1.0f / sqrtf(wave_sum(ss) * (1.0f / CONV_CH) + EPS);
            u32x4 wv; wv.x = PKM(v[0] * r2 * o8[0], v[1] * r2 * o8[1]); wv.y = PKM(v[2] * r2 * o8[2], v[3] * r2 * o8[3]); wv.z = PKM(v[4] * r2 * o8[4], v[5] * r2 * o8[5]); wv.w = PKM(v[6] * r2 * o8[6], v[7] * r2 * o8[7]);
            *(u32x4*)(MIX + (size_t)(r0 + 32 * jh + j) * D_MODEL + NSA_W + lane * 8) = wv; }
        __syncthreads();
    }
}
__device__ __forceinline__ void kprep(Frame& F, const Args& a) {
    const int gw = F.vcu * NWAVES + F.wave, NGW = F.G * NWAVES, lane = F.lane, l8 = lane & 7, sub = lane >> 3;
    const float* RC = (const float*)(F.ws + WS_ROPEC); const float* RS = (const float*)(F.ws + WS_ROPES);
    constexpr int NROWB = (2 * BATCH * NG * SEQ) / 8;
    for (int rb = gw; rb < NROWB; rb += NGW) {
        const int rowg = rb * 8 + sub; const int which = rowg >= BATCH * NG * SEQ; const int row = rowg - which * BATCH * NG * SEQ; const int t = row & 2047;
        const half_t* src = (const half_t*)(F.ws + (which ? WS_KWR : WS_KSR)) + (size_t)row * HD; half_t* dst = (half_t*)(F.ws + (which ? WS_KW : WS_KS)) + (size_t)row * HD;
        const float* gn = which ? a.in[6] : a.in[5];
        const h4 r1 = *(const h4*)(src + 4 * l8), r2 = *(const h4*)(src + 32 + 4 * l8);
        float v1[4], v2[4]; float ss = 0.f;
#pragma unroll
        for (int i = 0; i < 4; ++i) { v1[i] = (float)r1[i]; v2[i] = (float)r2[i]; ss += v1[i] * v1[i] + v2[i] * v2[i]; }
        ss += __shfl_xor(ss, 1); ss += __shfl_xor(ss, 2); ss += __shfl_xor(ss, 4);
        const float r = 1.0f / sqrtf(ss * (1.0f / HD) + EPS);
        const f32x4 cs = *(const f32x4*)(RC + t * 32 + 4 * l8), sn = *(const f32x4*)(RS + t * 32 + 4 * l8);
        float o1[4], o2[4];
#pragma unroll
        for (int i = 0; i < 4; ++i) { const float x1 = v1[i] * r * gn[4 * l8 + i], x2 = v2[i] * r * gn[32 + 4 * l8 + i]; o1[i] = x1 * cs[i] - x2 * sn[i]; o2[i] = x2 * cs[i] + x1 * sn[i]; }
        u32x2 w1; w1.x = pkh(o1[0], o1[1]); w1.y = pkh(o1[2], o1[3]); u32x2 w2; w2.x = pkh(o2[0], o2[1]); w2.y = pkh(o2[2], o2[3]);
        *(u32x2*)(dst + 4 * l8) = w1; *(u32x2*)(dst + 32 + 4 * l8) = w2;
    }
}
__device__ __forceinline__ void cmp_finalize(Frame& F, const Args& a) {
    const int gw = F.vcu * NWAVES + F.wave, NGW = F.G * NWAVES, lane = F.lane;
    const float* BP = (const float*)(F.ws + WS_BIASP); const float* HIDP = (const float*)(F.ws + WS_HIDP);
    const float* RC = (const float*)(F.ws + WS_ROPEC); const float* RS = (const float*)(F.ws + WS_ROPES);
    LAS float* W2L = (LAS float*)F.lds; const int kv_wg = (F.vcu * NWAVES) >> 10; const bool w2_lds = (F.G == 256);
    if (w2_lds) { const float* w2g = kv_wg ? a.in[12] : a.in[9];
#pragma unroll
        for (int k = 0; k < 8; ++k) { const int id = F.tid + 512 * k; *(LAS f32x4*)(W2L + id * 4) = *(const f32x4*)(w2g + id * 4); }
        __syncthreads(); }
    for (int it = gw; it < 2 * 16 * (NCMP_PAD / 2); it += NGW) {
        const int kv = it >> 10, row = (it & 1023) * 2, n = row & 127;
        f32x4 bias = {0.f, 0.f, 0.f, 0.f};
        for (int seg = 0; seg < 16; ++seg) bias += *(const f32x4*)(BP + (seg * 2 + kv) * CMP_HID + 4 * lane);
        f32x4 hv0 = bias, hv1 = bias;
#pragma unroll
        for (int ks = 0; ks < 8; ++ks) { const float* hp = HIDP + ((size_t)(kv * 8 + ks) * 2048 + row) * CMP_HID + 4 * lane; hv0 += *(const f32x4*)hp; hv1 += *(const f32x4*)(hp + CMP_HID); }
        float hs0[4], hs1[4];
#pragma unroll
        for (int i = 0; i < 4; ++i) { hs0[i] = hv0[i] * sigmoidf_(hv0[i]); hs1[i] = hv1[i] * sigmoidf_(hv1[i]); }
        const float* w2 = (kv ? a.in[12] : a.in[9]) + lane; float o0 = 0.f, o1 = 0.f;
#pragma unroll 2
        for (int jl = 0; jl < 64; ++jl) {
            float w[4];
#pragma unroll
            for (int i = 0; i < 4; ++i) w[i] = w2_lds ? W2L[(jl * 4 + i) * HD + lane] : w2[(jl * 4 + i) * HD];
#pragma unroll
            for (int i = 0; i < 4; ++i) { const float b0 = __int_as_float(__builtin_amdgcn_readlane(__float_as_int(hs0[i]), jl)), b1 = __int_as_float(__builtin_amdgcn_readlane(__float_as_int(hs1[i]), jl));
                o0 = __builtin_fmaf(b0, w[i], o0); o1 = __builtin_fmaf(b1, w[i], o1); }
        }
        half_t* dst = (half_t*)(F.ws + (kv ? WS_VCMP : WS_KCMP)) + (size_t)row * HD + lane;
        if (kv == 0) {
            const float gk = a.in[4][lane]; const int i = lane & 31;
            { const float r = 1.0f / sqrtf(wave_sum(o0 * o0) * (1.0f / HD) + EPS); const float xn = o0 * r * gk; const float other = __shfl_xor(xn, 32); const int pos = 16 * n + 31; const float cs = RC[pos * 32 + i], sn = RS[pos * 32 + i];
              o0 = lane < 32 ? xn * cs - other * sn : xn * cs + other * sn; }
            { const float r = 1.0f / sqrtf(wave_sum(o1 * o1) * (1.0f / HD) + EPS); const float xn = o1 * r * gk; const float other = __shfl_xor(xn, 32); const int pos = 16 * (n + 1) + 31; const float cs = RC[(pos & 2047) * 32 + i], sn = RS[(pos & 2047) * 32 + i];
              o1 = lane < 32 ? xn * cs - other * sn : xn * cs + other * sn; }
        }
        dst[0] = (half_t)o0;
        dst[HD] = (n + 1 == NCMP) ? (half_t)0.f : (half_t)o1;
    }
}

constexpr int A_CMPK = 0, A_CMPV = 32768, A_IMP = 65536, A_KS0 = 98304, A_KS1 = 114688, A_VS0 = 131072, A_VS1 = 65536, A_SSQ = 81920, A_OT = 0;
__device__ __forceinline__ int crow(int r, int hi) { return (r & 3) + 8 * (r >> 2) + 4 * hi; }
__device__ __forceinline__ s16x4 vtr(const LAS unsigned char* p) { return __builtin_bit_cast(s16x4, __builtin_amdgcn_ds_read_tr16_b64_v4i16((LAS s16x4*)p)); }
#define MFMA32(a, b, c) __builtin_amdgcn_mfma_f32_32x32x16_f16(a, b, c, 0, 0, 0)
__device__ __forceinline__ float xmax32(float v) { auto r = __builtin_amdgcn_permlane32_swap(__float_as_uint(v), __float_as_uint(v), false, false); return fmaxf(__uint_as_float(r[0]), __uint_as_float(r[1])); }
__device__ __forceinline__ float xsum32(float v) { auto r = __builtin_amdgcn_permlane32_swap(__float_as_uint(v), __float_as_uint(v), false, false); return __uint_as_float(r[0]) + __uint_as_float(r[1]); }
__device__ __forceinline__ float xget32(float v, int hi) { auto r = __builtin_amdgcn_permlane32_swap(__float_as_uint(v), __float_as_uint(v), false, false); return __uint_as_float(hi ? r[0] : r[1]); }

__device__ __forceinline__ f32x16 qk_lds(const LAS unsigned char* Kt, const h8 (&qf)[4], int r32, int hi) {
    f32x16 s = {};
    const LAS unsigned char* kp = Kt + r32 * 128; const int sw = (r32 >> 1) & 7;
#pragma unroll
    for (int d0 = 0; d0 < 4; ++d0) { const h8 kf = *(const LAS h8*)(kp + (((2 * d0 + hi) ^ sw) << 4)); s = MFMA32(kf, qf[d0], s); }
    return s;
}
__device__ __forceinline__ void pv_lds(f32x16 (&o)[2], const f32x16& p, const LAS unsigned char* Vt, int vb) {
#pragma unroll
    for (int s = 0; s < 2; ++s) {
        u32x4 pw; pw.x = pkh(p[8 * s + 0], p[8 * s + 1]); pw.y = pkh(p[8 * s + 2], p[8 * s + 3]); pw.z = pkh(p[8 * s + 4], p[8 * s + 5]); pw.w = pkh(p[8 * s + 6], p[8 * s + 7]);
        const h8 pf = __builtin_bit_cast(h8, pw);
#pragma unroll
        for (int dh = 0; dh < 2; ++dh) {
            const s16x4 lo = vtr(Vt + vb + dh * 2048 + s * 1024), hi4 = vtr(Vt + vb + dh * 2048 + s * 1024 + 512);
            const h8 vf = __builtin_bit_cast(h8, __builtin_shufflevector(lo, hi4, 0, 1, 2, 3, 4, 5, 6, 7));
            o[dh] = MFMA32(vf, pf, o[dh]);
        }
    }
}

__device__ __forceinline__ void attn_item(Frame& F, const Args& a, int b, int qt) {
    int tid = F.tid; asm volatile("" : "+v"(tid));
    const int lane = tid & 63, h = F.wave, g = h >> 2, r32 = lane & 31, hi = lane >> 5;
    const int t0 = qt * 32, t = t0 + r32, cur = qt >> 1;
    const size_t row = (size_t)b * SEQ + t;
    LAS unsigned char* lds = F.lds;
    LAS float* IMP = (LAS float*)(lds + A_IMP); LAS float* SSQ8 = (LAS float*)(lds + A_SSQ);
    const float* RC = (const float*)(F.ws + WS_ROPEC); const float* RS = (const float*)(F.ws + WS_ROPES);
    const int tg = tid >> 8, tkey = (tid >> 3) & 31, tc = tid & 7;
    const int kdst0 = tkey * 128 + ((tc ^ ((tkey >> 1) & 7)) << 4), vdst0 = (tc >> 2) * 2048 + tkey * 64 + (tc & 3) * 16;
    const int vb = (4 * hi + ((lane & 15) >> 2)) * 64 + ((lane >> 4) & 1) * 32 + (lane & 3) * 8;
    const int ntile = (qt >> 4) + 1;
    h8 qf[4]; f32x16 ot[2]; unsigned sel; u32x4 kr0, kr1, vr0, vr1, vq0, vq1; float m_s, m_w, qn2 = 0.f;
    const float* gt = (const float*)(F.ws + WS_GATES) + row * 24 + 3 * h;
    const float g_c = gt[0];
    const int n_s = cur + 1, kt0w = cur >= 8 ? cur - 8 : 0, nsteps = n_s + (cur - kt0w + 1);
    const unsigned kofb = (unsigned)((((b * 2 + tg) * SEQ + tkey) * HD + tc * 8) * 2);
#define ATT_TILE_BASE(wsoff_s, wsoff_w, i) (F.ws + ((i) < n_s ? (size_t)(wsoff_s) + (size_t)(i) * (64 * HD * 2) : (size_t)(wsoff_w) + (size_t)(kt0w + (i) - n_s) * (64 * HD * 2)))
#ifndef DUP_ATT_PRE
#define DUP_ATT_PRE 0
#endif
#pragma unroll 1
    for (int rep_ = 0; rep_ < (DUP_ATT_PRE ? 2 : 1); ++rep_) {
    {
        const size_t coff = ((size_t)((b * 2 + tg) * NCMP_PAD + tkey)) * HD + tc * 8;
        const half_t* Kc = (const half_t*)(F.ws + WS_KCMP) + coff; const half_t* Vc = (const half_t*)(F.ws + WS_VCMP) + coff;
        u32x4 kr[4], vr[4];
#pragma unroll
        for (int T = 0; T < 4; ++T) if (T < ntile) { kr[T] = *(const u32x4*)(Kc + T * 32 * HD); vr[T] = *(const u32x4*)(Vc + T * 32 * HD); }
#pragma unroll
        for (int T = 0; T < 4; ++T) if (T < ntile) { *(LAS u32x4*)(lds + A_CMPK + tg * 16384 + T * 4096 + kdst0) = kr[T]; *(LAS u32x4*)(lds + A_CMPV + tg * 16384 + T * 4096 + vdst0) = vr[T]; }
    }
    {
        const half_t* Qp = (const half_t*)(F.ws + WS_Q) + row * NSA_W + h * HD;
        float qv[4][8]; float ss = 0.f; qn2 = 0.f;
#pragma unroll
        for (int d0 = 0; d0 < 4; ++d0) { const h8 raw = *(const h8*)(Qp + 16 * d0 + 8 * hi);
#pragma unroll
            for (int j = 0; j < 8; ++j) { qv[d0][j] = (float)raw[j]; ss += qv[d0][j] * qv[d0][j]; } }
        ss = xsum32(ss);
        const float r = 1.0f / sqrtf(ss * (1.0f / HD) + EPS); const float* qg = a.in[3];
#pragma unroll
        for (int d0 = 0; d0 < 4; ++d0)
#pragma unroll
            for (int j = 0; j < 8; ++j) qv[d0][j] *= r * qg[16 * d0 + 8 * hi + j];
        const float sc = 0.125f * LOG2E;
#pragma unroll
        for (int d0 = 0; d0 < 2; ++d0) {
            float o1[8], o2[8];
#pragma unroll
            for (int j = 0; j < 8; ++j) { const int i = 16 * d0 + 8 * hi + j; const float cs = RC[t * 32 + i], sn = RS[t * 32 + i]; const float x1 = qv[d0][j], x2 = qv[d0 + 2][j];
                o1[j] = (x1 * cs - x2 * sn) * sc; o2[j] = (x2 * cs + x1 * sn) * sc; }
            u32x4 w1; w1.x = pkh(o1[0], o1[1]); w1.y = pkh(o1[2], o1[3]); w1.z = pkh(o1[4], o1[5]); w1.w = pkh(o1[6], o1[7]);
            u32x4 w2; w2.x = pkh(o2[0], o2[1]); w2.y = pkh(o2[2], o2[3]); w2.z = pkh(o2[4], o2[5]); w2.w = pkh(o2[6], o2[7]);
            qf[d0] = __builtin_bit_cast(h8, w1); qf[d0 + 2] = __builtin_bit_cast(h8, w2);
#pragma unroll
            for (int j = 0; j < 8; ++j) qn2 += o1[j] * o1[j] + o2[j] * o2[j];
        }
        qn2 = xsum32(qn2);
    }
    { const float qn = sqrtf(qn2) * 8.0f * 1.001f; const float* GM = (const float*)(F.ws + WS_GMAX); m_s = qn * GM[0] - 13.0f; m_w = qn * GM[1] - 13.0f; }
    { const unsigned char* k0p = ATT_TILE_BASE(WS_KS, WS_KW, 0); const unsigned char* k1p = ATT_TILE_BASE(WS_KS, WS_KW, 1);
      kr0 = *(const u32x4*)(k0p + kofb); kr1 = *(const u32x4*)(k0p + 4096 + kofb); vr0 = *(const u32x4*)(k1p + kofb); vr1 = *(const u32x4*)(k1p + 4096 + kofb);
      const unsigned char* v0p = ATT_TILE_BASE(WS_VS, WS_VW, 0); vq0 = *(const u32x4*)(v0p + kofb); vq1 = *(const u32x4*)(v0p + 4096 + kofb); }
    __syncthreads();
    {
        const LAS unsigned char* Kc = lds + A_CMPK + g * 16384; const LAS unsigned char* Vc = lds + A_CMPV + g * 16384;
        const int nmax = (t >= 31) ? ((t - 31) >> 4) : -1;
        float mx = -INFINITY;
#pragma unroll 1
        for (int T = 0; T < ntile; ++T) { f32x16 sc = qk_lds(Kc + T * 4096, qf, r32, hi);
#pragma unroll
            for (int r = 0; r < 16; ++r) { const int n = 32 * T + crow(r, hi); mx = fmaxf(mx, n > nmax ? -INFINITY : sc[r]); } }
        mx = xmax32(mx);
        const float mref = (nmax >= 0) ? mx : 0.f; float lsum = 0.f, carry = 0.f;
        f32x16 oc[2]; oc[0] = f32x16{}; oc[1] = f32x16{};
#pragma unroll 1
        for (int T = 0; T < ntile; ++T) { f32x16 pc = qk_lds(Kc + T * 4096, qf, r32, hi);
#pragma unroll
            for (int r = 0; r < 16; ++r) { const int n = 32 * T + crow(r, hi); pc[r] = __builtin_amdgcn_exp2f((n > nmax ? -INFINITY : pc[r]) - mref); lsum += pc[r]; }
            pv_lds(oc, pc, Vc + T * 4096, vb);
#pragma unroll
            for (int gq = 0; gq < 4; ++gq) {
                const float own = (pc[4 * gq] + pc[4 * gq + 1]) + (pc[4 * gq + 2] + 0.5f * pc[4 * gq + 3]);
                const float prevk3 = gq > 0 ? pc[gq > 0 ? 4 * gq - 1 : 0] : carry;
                const float recv = xget32(hi == 0 ? pc[4 * gq + 3] : prevk3, hi);
                IMP[(h * 32 + 8 * T + 2 * gq + hi) * 32 + r32] = own + 0.5f * recv;
            }
            carry = pc[15];
        }
        lsum = xsum32(lsum);
        const float inv = (nmax >= 0) ? 1.0f / lsum : 0.f;
#pragma unroll 1
        for (int T = 0; T < ntile; ++T)
#pragma unroll
            for (int gq = 0; gq < 4; ++gq) { LAS float* p = IMP + (h * 32 + 8 * T + 2 * gq + hi) * 32 + r32; *p = *p * inv; }
        const float gci = g_c * inv;
#pragma unroll
        for (int r = 0; r < 16; ++r) { ot[0][r] = gci * oc[0][r]; ot[1][r] = gci * oc[1][r]; }
        { LAS unsigned char* rb = lds + A_KS0 + tg * 8192; *(LAS u32x4*)(rb + kdst0) = kr0; *(LAS u32x4*)(rb + 4096 + kdst0) = kr1; *(LAS u32x4*)(rb + 16384 + kdst0) = vr0; *(LAS u32x4*)(rb + 16384 + 4096 + kdst0) = vr1;
          LAS unsigned char* vb0_ = lds + A_VS0 + tg * 8192; *(LAS u32x4*)(vb0_ + vdst0) = vq0; *(LAS u32x4*)(vb0_ + 4096 + vdst0) = vq1; }
        __syncthreads();
        if (cur + 1 <= 8) sel = (1u << (cur + 1)) - 1u;
        else {
            unsigned key[30];
#pragma unroll
            for (int j = 1; j < 30; ++j) { const LAS float* p = IMP + ((g * 4) * 32 + j) * 32 + r32; const float v = (p[0] + p[1024]) + (p[2048] + p[3072]);
                key[j] = (j <= cur - 2) ? ((__float_as_uint(v) & ~31u) | (unsigned)(31 - j)) : 0u; }
            sel = 1u | (1u << cur) | (1u << (cur - 1));
#pragma unroll 1
            for (int pass = 0; pass < 5; ++pass) { unsigned best = key[1];
#pragma unroll
                for (int j = 2; j < 30; ++j) best = best > key[j] ? best : key[j];
                sel |= 1u << (31u - (best & 31u));
#pragma unroll
                for (int j = 1; j < 30; ++j) key[j] = key[j] == best ? 0u : key[j]; }
        }
        __syncthreads();
    }
    }
    LAS unsigned char* OT = lds + A_OT + h * 8192 + lane * 16;
#pragma unroll
    for (int q = 0; q < 8; ++q) { f32x4 v; v[0] = ot[q >> 2][4 * (q & 3)]; v[1] = ot[q >> 2][4 * (q & 3) + 1]; v[2] = ot[q >> 2][4 * (q & 3) + 2]; v[3] = ot[q >> 2][4 * (q & 3) + 3]; *(LAS f32x4*)(OT + q * 1024) = v; }
    {
        float l_s = 0.f, l_w = 0.f; f32x16 o[2]; o[0] = f32x16{}; o[1] = f32x16{};
        u32x4 kra, krb, vra, vrb;
        const __amdgpu_buffer_rsrc_t wsrs = __builtin_amdgcn_make_buffer_rsrc(F.ws, 0, 0x10000000, 0x00020000);
#define ATT_TILE_OFF(wsoff_s, wsoff_w, i) ((unsigned)((i) < n_s ? (unsigned)(wsoff_s) + (unsigned)(i) * (64u * HD * 2) : (unsigned)(wsoff_w) + (unsigned)(kt0w + (i) - n_s) * (64u * HD * 2)))
#define ATT_ISSUE_K2(i, KA, KB) do { const unsigned so_ = ATT_TILE_OFF(WS_KS, WS_KW, i); KA = __builtin_amdgcn_raw_buffer_load_b128(wsrs, kofb, so_, 0); KB = __builtin_amdgcn_raw_buffer_load_b128(wsrs, kofb + 4096u, so_, 0); } while (0)
#define ATT_ISSUE_V2(i, VA, VB) do { const unsigned so_ = ATT_TILE_OFF(WS_VS, WS_VW, i); VA = __builtin_amdgcn_raw_buffer_load_b128(wsrs, kofb, so_, 0); VB = __builtin_amdgcn_raw_buffer_load_b128(wsrs, kofb + 4096u, so_, 0); } while (0)
        ATT_ISSUE_K2(2, kra, krb);
        ATT_ISSUE_V2(1, vra, vrb);
        f32x16 c0 = qk_lds(lds + A_KS0 + g * 8192, qf, r32, hi), c1 = qk_lds(lds + A_KS0 + g * 8192 + 4096, qf, r32, hi);
        asm volatile("s_waitcnt lgkmcnt(0)" ::: "memory"); __builtin_amdgcn_s_barrier(); asm volatile("" ::: "memory");
        f32x16 d0, d1;
        u32x4 pw0 = {0u, 0u, 0u, 0u}, pw1 = pw0, pw2 = pw0, pw3 = pw0;
        s16x4 vl[8], vh[8];
#pragma unroll
        for (int m_ = 0; m_ < 8; ++m_) { vl[m_] = (s16x4){0, 0, 0, 0}; vh[m_] = (s16x4){0, 0, 0, 0}; }
        LAS unsigned char* const kst_p = lds + A_KS0 + tg * 8192 + kdst0; const int vst_o = tg * 8192 + vdst0;
        const int vfr_o = g * 8192 + vb; int kfo[4];
#pragma unroll
        for (int d0_ = 0; d0_ < 4; ++d0_) kfo[d0_] = r32 * 128 + (((2 * d0_ + hi) ^ ((r32 >> 1) & 7)) << 4);
#define ATT_PIN(x) asm volatile("" : "+v"(x))
#define ATT_SB __builtin_amdgcn_sched_barrier(0)
#define ATT_VOFF(s_) ((s_) == 0 ? 0 : (s_) == 1 ? 1024 : (s_) == 2 ? 4096 : 5120)
#define ATT_VRD(m) do { vl[m] = vtr(vt_ + ((m) & 1) * 2048 + ATT_VOFF((m) >> 1)); vh[m] = vtr(vt_ + ((m) & 1) * 2048 + ATT_VOFF((m) >> 1) + 512); } while (0)
#define ATT_VF(m) __builtin_bit_cast(h8, __builtin_shufflevector(vl[m], vh[m], 0, 1, 2, 3, 4, 5, 6, 7))
#define ATT_KRD(m) do { kf[m] = *(const LAS h8*)(kt_ + ((m) & 1) * 4096 + kfo[(m) >> 1]); } while (0)
#define ATT_EX4(C, e) do { C[e] = __builtin_amdgcn_exp2f(C[e] - msub); C[(e) + 1] = __builtin_amdgcn_exp2f(C[(e) + 1] - msub); C[(e) + 2] = __builtin_amdgcn_exp2f(C[(e) + 2] - msub); C[(e) + 3] = __builtin_amdgcn_exp2f(C[(e) + 3] - msub); \
            rs += C[e]; rs += C[(e) + 1]; rs += C[(e) + 2]; rs += C[(e) + 3]; ATT_PIN(C); ATT_PIN(rs); } while (0)
#define ATT_PK4(C, e, WA, WB) do { WA = pkh(C[e], C[(e) + 1]); WB = pkh(C[(e) + 2], C[(e) + 3]); ATT_PIN(WA); ATT_PIN(WB); } while (0)
#define ATT_IT(j, C0, C1, N0, N1) do { \
            { LAS unsigned char* kb_ = kst_p + (((j) & 1) ? (A_KS1 - A_KS0) : 0); *(LAS u32x4*)(kb_) = kra; *(LAS u32x4*)(kb_ + 4096) = krb; }         \
            { LAS unsigned char* vb_ = lds + ((((j) + 1) & 1) ? A_VS1 : A_VS0) + vst_o; *(LAS u32x4*)(vb_) = vra; *(LAS u32x4*)(vb_ + 4096) = vrb; }      \
            ATT_ISSUE_K2((j) + 3, kra, krb); ATT_ISSUE_V2((j) + 2, vra, vrb);                    \
            const bool is_s_ = (j) < n_s; const int kt_i = is_s_ ? (j) : kt0w + (j) - n_s, kb_i = 64 * kt_i; \
            if (__builtin_expect(kt_i == cur || (!is_s_ && kt_i == cur - 8), 0)) { \
                _Pragma("unroll") for (int r = 0; r < 16; ++r) { const int key = kb_i + crow(r, hi); if (key > t || key <= t - 512) C0[r] = -INFINITY; if (key + 32 > t || key + 32 <= t - 512) C1[r] = -INFINITY; } } \
            const bool en_ = is_s_ ? ((sel >> kt_i) & 1u) : true; const float msub = en_ ? (is_s_ ? m_s : m_w) : INFINITY; float rs = 0.f; \
            const LAS unsigned char* vt_ = lds + (((j) & 1) ? A_VS1 : A_VS0) + vfr_o;                \
            const LAS unsigned char* kt_ = lds + ((((j) + 1) & 1) ? A_KS1 : A_KS0) + g * 8192;        \
            h8 kf[8]; \
            const h8 p0_ = __builtin_bit_cast(h8, pw0), p1_ = __builtin_bit_cast(h8, pw1), p2_ = __builtin_bit_cast(h8, pw2), p3_ = __builtin_bit_cast(h8, pw3); \
            ATT_SB; \
            o[0] = MFMA32(ATT_VF(0), p0_, o[0]); ATT_KRD(0); ATT_EX4(C0, 0); ATT_SB; \
            o[1] = MFMA32(ATT_VF(1), p0_, o[1]); ATT_KRD(1); ATT_EX4(C0, 4); ATT_SB; \
            o[0] = MFMA32(ATT_VF(2), p1_, o[0]); ATT_KRD(2); ATT_EX4(C0, 8); ATT_SB; \
            o[1] = MFMA32(ATT_VF(3), p1_, o[1]); ATT_KRD(3); ATT_EX4(C0, 12); ATT_SB; \
            o[0] = MFMA32(ATT_VF(4), p2_, o[0]); ATT_KRD(4); ATT_EX4(C1, 0); ATT_SB; \
            o[1] = MFMA32(ATT_VF(5), p2_, o[1]); ATT_KRD(5); ATT_EX4(C1, 4); ATT_SB; \
            o[0] = MFMA32(ATT_VF(6), p3_, o[0]); ATT_KRD(6); ATT_EX4(C1, 8); ATT_SB; \
            o[1] = MFMA32(ATT_VF(7), p3_, o[1]); ATT_KRD(7); ATT_EX4(C1, 12); ATT_SB; \
            N0 = MFMA32(kf[0], qf[0], (f32x16){}); ATT_VRD(0); ATT_PK4(C0, 0, pw0.x, pw0.y); ATT_SB; \
            N1 = MFMA32(kf[1], qf[0], (f32x16){}); ATT_VRD(1); ATT_PK4(C0, 4, pw0.z, pw0.w); ATT_SB; \
            N0 = MFMA32(kf[2], qf[1], N0); ATT_VRD(2); ATT_PK4(C0, 8, pw1.x, pw1.y); ATT_SB; \
            N1 = MFMA32(kf[3], qf[1], N1); ATT_VRD(3); ATT_PK4(C0, 12, pw1.z, pw1.w); ATT_SB; \
            N0 = MFMA32(kf[4], qf[2], N0); ATT_VRD(4); ATT_PK4(C1, 0, pw2.x, pw2.y); ATT_SB; \
            N1 = MFMA32(kf[5], qf[2], N1); ATT_VRD(5); ATT_PK4(C1, 4, pw2.z, pw2.w); ATT_SB; \
            N0 = MFMA32(kf[6], qf[3], N0); ATT_VRD(6); ATT_PK4(C1, 8, pw3.x, pw3.y); ATT_SB; \
            N1 = MFMA32(kf[7], qf[3], N1); ATT_VRD(7); ATT_PK4(C1, 12, pw3.z, pw3.w); ATT_SB; \
            l_s += is_s_ ? rs : 0.f; l_w += is_s_ ? 0.f : rs; \
            __syncthreads(); } while (0)
        int j = 0;
#pragma unroll 1
        for (; j + 1 <= n_s; j += 2) { ATT_IT(j, c0, c1, d0, d1); ATT_IT(j + 1, d0, d1, c0, c1); }
        if (j <= n_s) { ATT_IT(j, c0, c1, d0, d1); ++j; }
        { const float f_ = gt[1] / xsum32(l_s);
#pragma unroll
          for (int q = 0; q < 8; ++q) { f32x4 v_ = *(LAS f32x4*)(OT + q * 1024);
#pragma unroll
              for (int e = 0; e < 4; ++e) { v_[e] += f_ * o[q >> 2][4 * (q & 3) + e]; o[q >> 2][4 * (q & 3) + e] = 0.f; } *(LAS f32x4*)(OT + q * 1024) = v_; } }
        if ((j & 1) && j < nsteps) { ATT_IT(j, d0, d1, c0, c1); ++j; }
#pragma unroll 1
        for (; j < nsteps; j += 2) { ATT_IT(j, c0, c1, d0, d1); if (j + 1 < nsteps) ATT_IT(j + 1, d0, d1, c0, c1); }
        {
            const h8 p0_ = __builtin_bit_cast(h8, pw0), p1_ = __builtin_bit_cast(h8, pw1), p2_ = __builtin_bit_cast(h8, pw2), p3_ = __builtin_bit_cast(h8, pw3);
            o[0] = MFMA32(ATT_VF(0), p0_, o[0]); o[1] = MFMA32(ATT_VF(1), p0_, o[1]); o[0] = MFMA32(ATT_VF(2), p1_, o[0]); o[1] = MFMA32(ATT_VF(3), p1_, o[1]);
            o[0] = MFMA32(ATT_VF(4), p2_, o[0]); o[1] = MFMA32(ATT_VF(5), p2_, o[1]); o[0] = MFMA32(ATT_VF(6), p3_, o[0]); o[1] = MFMA32(ATT_VF(7), p3_, o[1]);
        }
#undef ATT_IT
#undef ATT_EX4
#undef ATT_PK4
#undef ATT_VRD
#undef ATT_VF
#undef ATT_KRD
#undef ATT_ISSUE_K2
#undef ATT_ISSUE_V2
#undef ATT_TILE_OFF
        const float f = gt[2] / xsum32(l_w);
#pragma unroll
        for (int q = 0; q < 8; ++q) { const f32x4 v = *(LAS f32x4*)(OT + q * 1024);
#pragma unroll
            for (int e = 0; e < 4; ++e) ot[q >> 2][4 * (q & 3) + e] = v[e] + f * o[q >> 2][4 * (q & 3) + e]; }
    }
    {
        float ss = 0.f;
#pragma unroll
        for (int r = 0; r < 16; ++r) ss += ot[0][r] * ot[0][r] + ot[1][r] * ot[1][r];
        ss = xsum32(ss);
        if (hi == 0) SSQ8[h * 32 + r32] = ss;
        __syncthreads();
        float tot = 0.f;
#pragma unroll
        for (int hh = 0; hh < 8; ++hh) tot += SSQ8[hh * 32 + r32];
        const float rn = 1.0f / sqrtf(tot * (1.0f / NSA_W) + EPS);
        const float* og = a.in[17] + h * HD; half_t* dst = (half_t*)(F.ws + WS_MIX) + row * D_MODEL + h * HD;
#pragma unroll
        for (int dh = 0; dh < 2; ++dh)
#pragma unroll
            for (int q4 = 0; q4 < 4; ++q4) { const int d = 32 * dh + 8 * q4 + 4 * hi; const f32x4 gv = *(const f32x4*)(og + d);
                u32x2 w; w.x = PKM(ot[dh][4 * q4] * rn * gv[0], ot[dh][4 * q4 + 1] * rn * gv[1]); w.y = PKM(ot[dh][4 * q4 + 2] * rn * gv[2], ot[dh][4 * q4 + 3] * rn * gv[3]);
                *(u32x2*)(dst + d) = w; }
        __syncthreads();
    }
}

__global__ void __launch_bounds__(NWAVES * 64, 2) fwd_kernel(Args args) {
    extern __shared__ __attribute__((aligned(16))) unsigned char lds_raw[];
    Frame F;
    F.lds = (LAS unsigned char*)lds_raw;
    F.tid = threadIdx.x; F.lane = F.tid & 63; F.wave = __builtin_amdgcn_readfirstlane(F.tid >> 6);
    F.G = gridDim.x; { const int bx = blockIdx.x; F.vcu = (F.G % 8 == 0) ? (bx % 8) * (F.G / 8) + bx / 8 : bx; }
    F.ws = args.ws;
    volatile LAS unsigned* MISC = (volatile LAS unsigned*)(F.lds + MISC_OFF);
    for (int u = F.tid; u < (LDS_BYTES - LDSCTL_OFF) / 4; u += NWAVES * 64) ((LAS unsigned*)(F.lds + LDSCTL_OFF))[u] = 0u;
    __syncthreads();
    unsigned* ctl = (unsigned*)(args.ws + WS_CTL);
    XcdBarrier bar = xcd_barrier_post(ctl + CW_BAR + args.li * XCD_BAR_WORDS, MISC + 8);
    const int lo = args.ph_lo, hi = args.ph_hi;
#ifdef ONLY_PHASE
#define IN(k) ((k) == ONLY_PHASE && lo <= (k) && (k) < hi)
#else
#define IN(k) (lo <= (k) && (k) < hi)
#endif
#define SEAM(k) do { if (IN(k) && IN((k) + 1)) xcd_barrier(bar); } while (0)
    half_t* const wsH = (half_t*)args.ws;
#define WSH(off) ((half_t*)(args.ws + (off)))

#define RUN2(k, ...) do { if (IN(k)) { __VA_ARGS__ if (DUP_PHASE == (k)) { __VA_ARGS__ } } } while (0)
    RUN2(0, { p0_prologue(F, args); });
    SEAM(0);
    RUN2(1, {
        pg8::Gemm g{WSH(WS_XN), WSH(WS_WIN), M, IN_PAD, 1024, 1024, 1024}; pg8::StaticOrder S; S.init(M, IN_PAD, F.G, (int)blockIdx.x);
        pg8::EpiInProj E{args.ws};
        pg8::gemm_phase<pg8::EpiInProj, pg8::StaticOrder, true, IN_BF16 != 0>(F.lds, g, S, E);
        if (F.G == 256) { if ((int)blockIdx.x >= 128) late_weights(F, args, ((int)blockIdx.x - 128) * NWAVES + F.wave, 128 * NWAVES); }
        else late_weights(F, args, (int)blockIdx.x * NWAVES + F.wave, F.G * NWAVES);
    });
    SEAM(1);
    RUN2(2, {
        for (int it = F.vcu; it < M / 64; it += F.G) conv_item(F, args, it);
        kprep(F, args);
        __syncthreads();
        {
            const int c = (int)blockIdx.x; const int kv = (c >> 6) & 1, pmu = (c >> 3) & 7, ks = c & 7;
            pg8::Gemm gk{WSH(WS_KC) + (size_t)kv * (KV6_STRIDE / 2) + (size_t)pmu * 256 * 1024 + ks * 256, WSH(WS_W1K) + (size_t)kv * ((WS_W1V - WS_W1K) / 2) + ks * 256, 256, 256, 256, 1024, 2048};
            pg8::SingleOrder Sk{c < 128};
            pg8::EpiF32 Ek{(float*)(args.ws + WS_HIDP) + ((size_t)(kv * 8 + ks) * 2048 + pmu * 256) * CMP_HID, CMP_HID};
            pg8::gemm_phase<pg8::EpiF32, pg8::SingleOrder, false>(F.lds, gk, Sk, Ek);
        }
    });
    SEAM(2);
    RUN2(3, { cmp_finalize(F, args); });
    SEAM(3);
    RUN2(4, {
        for (int it = F.vcu; it < 512; it += F.G) { const int v = it & 255; const int b = v >> 5; const int s = v & 31; attn_item(F, args, b, it < 256 ? s : 63 - s); }
    });
    SEAM(4);
    RUN2(5, {
        pg8::Gemm g{WSH(WS_MIX), WSH(WS_WOUT), M, 1024, 1024, 1024, 1024}; pg8::StaticOrder S; S.init(M, 1024, F.G, (int)blockIdx.x);
        pg8::EpiOutProj E{args.in[0], WSH(WS_H1H), (float*)(args.ws + WS_SSQ)};
        pg8::gemm_phase<pg8::EpiOutProj, pg8::StaticOrder, false, MIX_BF16 != 0>(F.lds, g, S, E);
    });
    SEAM(5);
    RUN2(6, {
        pg8::Gemm g{WSH(WS_H1H), WSH(WS_WGU), M, 2 * FFN, 1024, 1024, 1024}; pg8::StaticOrder S; S.init(M, 2 * FFN, F.G, (int)blockIdx.x);
        LAS float* RT = (LAS float*)(F.lds + RING_BYTES);
        { const float* SSQ = (const float*)(args.ws + WS_SSQ);
          for (int idx = F.tid; idx < 8 * 256; idx += NWAVES * 64) { const int row = (8 * ((int)blockIdx.x & 7) + (idx >> 8)) * 256 + (idx & 255); const f32x4 sq = *(const f32x4*)(SSQ + (size_t)row * 4);
              RT[idx] = __builtin_amdgcn_rsqf(((sq[0] + sq[1]) + (sq[2] + sq[3])) * (1.0f / D_MODEL) + EPS); }
          __syncthreads(); }
        if (F.G == 256) {
            S.maxr = 5;
            pg8::EpiGateUp E{RT, args.ws, false};
            pg8::gemm_phase<pg8::EpiGateUp, pg8::StaticOrder, true, FFN_BF16 != 0>(F.lds, g, S, E);
            pg8::TailHalfOrder T{S, 5}; T.S.maxr = 1 << 30;
            pg8::EpiGateUp Eh{RT, args.ws, true};
            pg8::gemm_phase<pg8::EpiGateUp, pg8::TailHalfOrder, false, FFN_BF16 != 0, true>(F.lds, g, T, Eh);
        } else {
            pg8::EpiGateUp E{RT, args.ws, false};
            pg8::gemm_phase<pg8::EpiGateUp, pg8::StaticOrder, true, FFN_BF16 != 0>(F.lds, g, S, E);
        }
    });
    SEAM(6);
    RUN2(7, {
        pg8::Gemm g{WSH(WS_HB), WSH(WS_WDN), M, 1024, FFN, FFN, FFN}; pg8::StaticOrder S; S.init(M, 1024, F.G, (int)blockIdx.x);
        pg8::EpiDown E{WSH(WS_H1H), args.out};
        pg8::gemm_phase<pg8::EpiDown, pg8::StaticOrder, false, FFN_BF16 != 0>(F.lds, g, S, E);
    });
#undef RUN2
    (void)wsH;
#undef IN
#undef SEAM
#undef WSH
}

extern "C" void kernel_launch(void* const* d_in, const int* in_sizes, int n_in, void* d_out, int out_size, void* d_ws, size_t ws_size, hipStream_t stream) {
    static int grid = 0;
    if (grid == 0) {
        if (n_in != 23 || in_sizes[0] != M * D_MODEL || out_size != M * D_MODEL || ws_size < WS_END) { fprintf(stderr, "kernel_launch: unexpected shapes (n_in %d, in0 %d, out %d, ws %zu)\n", n_in, n_in > 0 ? in_sizes[0] : -1, out_size, ws_size); grid = -1; return; }
        int dev = 0, cus = 0;
        if (hipGetDevice(&dev) != hipSuccess || hipDeviceGetAttribute(&cus, hipDeviceAttributeMultiprocessorCount, dev) != hipSuccess) { grid = -1; return; }
        if (hipFuncSetAttribute((const void*)fwd_kernel, hipFuncAttributeMaxDynamicSharedMemorySize, LDS_BYTES) != hipSuccess) { fprintf(stderr, "kernel_launch: hipFuncSetAttribute failed\n"); grid = -1; return; }
        int per_cu = 0;
        if (hipOccupancyMaxActiveBlocksPerMultiprocessor(&per_cu, (const void*)fwd_kernel, NWAVES * 64, LDS_BYTES) != hipSuccess || per_cu < 1) fprintf(stderr, "kernel_launch: occupancy query says %d\n", per_cu);
        (void)hipGetLastError();
        grid = cus;
        if (grid != 256) fprintf(stderr, "kernel_launch: %d CUs (built for 256)\n", grid);
    }
    if (grid < 0) return;
    (void)hipMemsetAsync((char*)d_ws + WS_CTL, 0, CTL_ZERO_BYTES, stream);
    Args a{};
    for (int i = 0; i < 23; ++i) a.in[i] = (const float*)d_in[i];
    a.out = (float*)d_out; a.ws = (unsigned char*)d_ws;
#if MK_N_LAUNCHES == 1
    a.ph_lo = 0; a.ph_hi = N_PHASES; a.li = 0;
    hipLaunchKernelGGL(fwd_kernel, dim3(grid), dim3(NWAVES * 64), LDS_BYTES, stream, a);
#else
    for (int p = 0; p < N_PHASES; ++p) { a.ph_lo = p; a.ph_hi = p + 1; a.li = p; hipLaunchKernelGGL(fwd_kernel, dim3(grid), dim3(NWAVES * 64), LDS_BYTES, stream, a); }
#endif
}
```

```cpp
#include <hip/hip_runtime.h>
#include <cstdio>
#include <cstdint>

#ifndef MK_N_LAUNCHES
#define MK_N_LAUNCHES 1
#endif
#ifndef DUP_PHASE
#define DUP_PHASE -1
#endif

typedef _Float16 half_t;
typedef _Float16 h8 __attribute__((ext_vector_type(8)));
typedef _Float16 h4 __attribute__((ext_vector_type(4)));
typedef _Float16 h2 __attribute__((ext_vector_type(2)));
typedef float f32x2 __attribute__((ext_vector_type(2)));
typedef float f32x4 __attribute__((ext_vector_type(4)));
typedef float f32x16 __attribute__((ext_vector_type(16)));
typedef unsigned u32x2 __attribute__((ext_vector_type(2)));
typedef unsigned u32x4 __attribute__((ext_vector_type(4)));
typedef short s16x4 __attribute__((ext_vector_type(4)));

#define LAS __attribute__((address_space(3)))
#define GAS __attribute__((address_space(1)))

constexpr int D_MODEL = 1024, BATCH = 8, SEQ = 2048, M = BATCH * SEQ;
constexpr int HD = 64, NH = 8, NG = 2, NSA_W = 512, CONV_CH = 512;
constexpr int NCMP = 127, NCMP_PAD = 128, CMP_HID = 256;
constexpr int FFN = 2816, IN_W = 2328, IN_PAD = 2560;
constexpr float EPS = 1e-6f;
constexpr float LOG2E = 1.4426950408889634f;

__device__ __forceinline__ unsigned pkh(float lo, float hi) { f32x2 v = {lo, hi}; h2 h = __builtin_convertvector(v, h2); return __builtin_bit_cast(unsigned, h); }
typedef __bf16 b2 __attribute__((ext_vector_type(2)));
typedef __bf16 b8 __attribute__((ext_vector_type(8)));
__device__ __forceinline__ unsigned pkb(float lo, float hi) { f32x2 v = {lo, hi}; b2 h = __builtin_convertvector(v, b2); return __builtin_bit_cast(unsigned, h); }
#ifndef FFN_BF16
#define FFN_BF16 1
#endif
#ifndef IN_BF16
#define IN_BF16 1
#endif
#ifndef MIX_BF16
#define MIX_BF16 1
#endif
#define PKM(lo, hi) (MIX_BF16 ? pkb(lo, hi) : pkh(lo, hi))
#define PKI(lo, hi) (IN_BF16 ? pkb(lo, hi) : pkh(lo, hi))
__device__ __forceinline__ float sigmoidf_(float x) { return __builtin_amdgcn_rcpf(1.0f + __builtin_amdgcn_exp2f(-x * LOG2E)); }
__device__ __forceinline__ float wave_sum(float v) {
#pragma unroll
    for (int o = 1; o < 64; o <<= 1) v += __shfl_xor(v, o);
    return v;
}

namespace pg8 {
constexpr int BM = 256, BK = 64, HALF = 128, HTB = HALF * BK * 2, STAGE_BYTES = 8 * HTB, NXCD = 8, WGM = 8;
__host__ __device__ __forceinline__ int lds_byte(int r, int c) { const int st = (r >> 4) * 2 + (c >> 5), rr = r & 15, cc = c & 31, ob = rr * 64 + cc * 2; return st * 1024 + (ob ^ (((ob >> 9) & 1) << 5)); }
__host__ __device__ __forceinline__ void stage_rc(int b, int& R, int& C) { const int st = b / 1024, sb = b % 1024, swz = sb ^ (((sb >> 9) & 1) << 5); R = (st >> 1) * 16 + swz / 64; C = (st & 1) * 32 + (swz % 64) / 2; }
__host__ __device__ __forceinline__ int perm32(int rho) { const int n = rho >> 4, i = rho & 15; return 8 * (i >> 2) + 4 * n + (i & 3); }

struct Unit { int pm, pn, hh; };
struct Gemm { const half_t* A; const half_t* Bt; int M, N, K, lda, ldb; };

struct StaticOrder {
    int nM, nN, nwg, G, c, maxr;
    __host__ __device__ void init(int M_, int N_, int G_, int c_) { nM = M_ / BM; nN = N_ / BM; nwg = nM * nN; G = G_; c = c_; maxr = 1 << 30; }
    __host__ __device__ bool next(int i, Unit& u) const {
        const long L = (long)i * G + c; if (L >= nwg || i >= maxr) return false; u.hh = 0;
        int wgid = (int)L; { const int q = nwg / NXCD, r = nwg % NXCD, xcd = wgid % NXCD, off = wgid / NXCD; wgid = (xcd < r ? xcd * (q + 1) : r * (q + 1) + (xcd - r) * q) + off; }
        const int nig = WGM * nN, gid = wgid / nig, fm = gid * WGM, gsz = (nM - fm) < WGM ? (nM - fm) : WGM;
        u.pm = fm + ((wgid % nig) % gsz); u.pn = (wgid % nig) / gsz; return true;
    }
};

struct SingleOrder { bool has; __device__ bool next(int i, Unit& u) const { if (i == 0 && has) { u.pm = 0; u.pn = 0; u.hh = 0; return true; } return false; } };
struct TailHalfOrder { StaticOrder S; int r;
    __device__ bool next(int i, Unit& u) const { if (i != 0) return false; StaticOrder T = S; const int half = S.G / 2; T.c = S.c % half; if (!T.next(r, u)) return false; u.hh = S.c / half; return true; } };
template <class Epi, class Sched, bool ALIGN_EPI, bool BF = false, bool HALFM = false>
__device__ __forceinline__ void gemm_phase(LAS unsigned char* lds, const Gemm g, const Sched& S, const Epi& E) {
    const int tid = threadIdx.x, wid = __builtin_amdgcn_readfirstlane(tid >> 6), lane = tid & 63, wr = wid >> 2, wc = wid & 3, fr = lane & 15, fq = lane >> 4;
    const int K = g.K, nt = K / BK;
    unsigned voffA[2], voffB[2];
#pragma unroll
    for (int i = 0; i < 2; ++i) { int R, C; stage_rc(tid * 16 + i * 8192, R, C); const int Rb = Epi::PERM ? ((R & ~31) + perm32(R & 31)) : R;
        voffA[i] = (unsigned)(R * g.lda + C) * 2u; voffB[i] = (unsigned)(Rb * g.ldb + C) * 2u; }
    const size_t kstep = (size_t)(BK * 2);
    const size_t hstepA = (size_t)HALF * g.lda * 2, hstepB = (size_t)HALF * g.ldb * 2;
    const size_t tstepA = 2 * hstepA, tstepB = 2 * hstepB;
    const unsigned ldsw = (unsigned)wid * 1024u;
    const int aoff = lds_byte(wr * 64 + fr, fq * 8), boff = lds_byte(wc * 32 + fr, fq * 8);
#define PG8_SA(b, h) (((b) * 2 + (h)) * HTB)
#define PG8_SB(b, h) ((4 + (b) * 2 + (h)) * HTB)
#define PG8_STAGE(bufoff, gbase, voff) do { _Pragma("unroll") for (int _i = 0; _i < 2; ++_i) \
        __builtin_amdgcn_global_load_lds((const unsigned*)((const char*)(gbase) + (voff)[_i]), (LAS unsigned*)(lds + (bufoff) + ldsw + _i * 8192), 16, 0, 0); } while (0)
#define PG8_LDA(dst, b, h) do { _Pragma("unroll") for (int m = 0; m < 4; ++m) _Pragma("unroll") for (int k = 0; k < 2; ++k) dst[m][k] = *(const LAS h8*)(lds + PG8_SA(b, h) + aoff + m * 2048 + k * 1024); } while (0)
#define PG8_LDB(dst, b, h) do { _Pragma("unroll") for (int n = 0; n < 2; ++n) _Pragma("unroll") for (int k = 0; k < 2; ++k) dst[n][k] = *(const LAS h8*)(lds + PG8_SB(b, h) + boff + n * 2048 + k * 1024); } while (0)
#define PG8_MMA(ai, bj, At, Bt) do { __builtin_amdgcn_s_setprio(1); _Pragma("unroll") for (int m = 0; m < 4; ++m) _Pragma("unroll") for (int n = 0; n < 2; ++n) _Pragma("unroll") for (int k = 0; k < 2; ++k) \
        acc[ai][bj][m][n] = BF ? __builtin_amdgcn_mfma_f32_16x16x32_bf16(__builtin_bit_cast(b8, Bt[n][k]), __builtin_bit_cast(b8, At[m][k]), acc[ai][bj][m][n], 0, 0, 0) \
                               : __builtin_amdgcn_mfma_f32_16x16x32_f16(Bt[n][k], At[m][k], acc[ai][bj][m][n], 0, 0, 0); __builtin_amdgcn_s_setprio(0); } while (0)
#define PG8_WAIT_V(n) asm volatile("s_waitcnt vmcnt(" #n ")" ::: "memory")
#define PG8_WAIT_L(n) asm volatile("s_waitcnt lgkmcnt(" #n ")" ::: "memory")
#define PG8_BAR __builtin_amdgcn_s_barrier()
#define PG8_SCHED __builtin_amdgcn_sched_barrier(0)
    Unit cur, nxt; int ui = 0;
    if (!S.next(0, cur)) return;
    f32x4 acc[2][2][4][2];
#pragma unroll
    for (int a = 0; a < 2; ++a)
#pragma unroll
        for (int b = 0; b < 2; ++b)
#pragma unroll
            for (int m = 0; m < 4; ++m)
#pragma unroll
                for (int n = 0; n < 2; ++n) acc[a][b][m][n] = (f32x4){0.f, 0.f, 0.f, 0.f};
    h8 At[4][2], B0[2][2], B1[2][2];
    const char* cA = (const char*)g.A + (size_t)cur.pm * tstepA + (HALFM ? (size_t)cur.hh * hstepA : 0); const char* cB = (const char*)g.Bt + (size_t)cur.pn * tstepB;
#define PG8_STAGE_A1(bufoff, gbase, voff) do { if (!HALFM) PG8_STAGE(bufoff, gbase, voff); } while (0)
#define PG8_WAIT_VH(n_full, n_half) do { if (HALFM) PG8_WAIT_V(n_half); else PG8_WAIT_V(n_full); } while (0)
    PG8_STAGE(PG8_SB(0, 0), cB, voffB); PG8_STAGE(PG8_SB(0, 1), cB + hstepB, voffB); PG8_STAGE(PG8_SA(0, 0), cA, voffA); PG8_STAGE_A1(PG8_SA(0, 1), cA + hstepA, voffA);
    if (wr == 1) PG8_BAR;
    PG8_WAIT_VH(2, 0); PG8_BAR;
    PG8_STAGE(PG8_SB(1, 0), cB + kstep, voffB); PG8_STAGE(PG8_SA(1, 0), cA + kstep, voffA); PG8_STAGE(PG8_SB(1, 1), cB + hstepB + kstep, voffB);
    PG8_WAIT_V(6); PG8_BAR;
    for (;;) {
        const bool has_next = S.next(ui + 1, nxt);
        const char* nA = has_next ? (const char*)g.A + (size_t)nxt.pm * tstepA + (HALFM ? (size_t)nxt.hh * hstepA : 0) : cA; const char* nB = has_next ? (const char*)g.Bt + (size_t)nxt.pn * tstepB : cB;
        for (int t = 0; t < nt; t += 2) {
            const bool last = (t == nt - 2);
            const char* a1 = cA + (size_t)(t + 1) * kstep;
            const char* a2 = last ? nA : cA + (size_t)(t + 2) * kstep; const char* b2 = last ? nB : cB + (size_t)(t + 2) * kstep;
            const char* a3 = a2 + kstep; const char* b3 = b2 + kstep;
            PG8_LDB(B0, 0, 0); PG8_LDB(B1, 0, 1); PG8_SCHED; PG8_LDA(At, 0, 0); PG8_STAGE_A1(PG8_SA(1, 1), a1 + hstepA, voffA);
            PG8_WAIT_VH(8, 6); PG8_WAIT_L(0); PG8_BAR; PG8_MMA(0, 0, At, B0); PG8_MMA(0, 1, At, B1); PG8_BAR; PG8_SCHED;
            if (!HALFM) PG8_LDA(At, 0, 1); PG8_STAGE(PG8_SB(0, 0), b2, voffB); PG8_STAGE(PG8_SB(0, 1), b2 + hstepB, voffB); PG8_STAGE(PG8_SA(0, 0), a2, voffA);
            PG8_WAIT_VH(8, 6); PG8_WAIT_L(0); PG8_BAR; if (!HALFM) { PG8_MMA(1, 0, At, B0); PG8_MMA(1, 1, At, B1); } PG8_BAR; PG8_SCHED;
            PG8_LDB(B0, 1, 0); PG8_LDB(B1, 1, 1); PG8_SCHED; PG8_LDA(At, 1, 0); PG8_STAGE_A1(PG8_SA(0, 1), a2 + hstepA, voffA);
            PG8_WAIT_VH(8, 6); PG8_WAIT_L(0); PG8_BAR; PG8_MMA(0, 0, At, B0); PG8_MMA(0, 1, At, B1); PG8_BAR; PG8_SCHED;
            if (!HALFM) PG8_LDA(At, 1, 1); PG8_STAGE(PG8_SB(1, 0), b3, voffB); PG8_STAGE(PG8_SB(1, 1), b3 + hstepB, voffB); PG8_STAGE(PG8_SA(1, 0), a3, voffA);
            PG8_WAIT_VH(8, 6); PG8_WAIT_L(0); PG8_BAR; if (!HALFM) { PG8_MMA(1, 0, At, B0); PG8_MMA(1, 1, At, B1); } PG8_BAR; PG8_SCHED;
        }
        if constexpr (ALIGN_EPI) { if (wr == 0) PG8_BAR; }
        if constexpr (!Epi::AFTER_DRAIN) { E(acc, cur, wr, wc, fr, fq); }
        if (!has_next) break;
#pragma unroll
        for (int a = 0; a < 2; ++a)
#pragma unroll
            for (int b = 0; b < 2; ++b)
#pragma unroll
                for (int m = 0; m < 4; ++m)
#pragma unroll
                    for (int n = 0; n < 2; ++n) acc[a][b][m][n] = (f32x4){0.f, 0.f, 0.f, 0.f};
        cur = nxt; cA = nA; cB = nB; ++ui;
        if constexpr (ALIGN_EPI) { if (wr == 1) PG8_BAR; }
    }
    PG8_WAIT_V(0);
    if constexpr (!ALIGN_EPI) { if (wr == 0) PG8_BAR; }
    PG8_BAR;
    if constexpr (Epi::AFTER_DRAIN) { E.fused(acc, cur, wr, wc, fr, fq, lds, wid, lane); }
#undef PG8_SA
#undef PG8_SB
#undef PG8_STAGE
#undef PG8_STAGE_A1
#undef PG8_WAIT_VH
#undef PG8_LDA
#undef PG8_LDB
#undef PG8_MMA
#undef PG8_WAIT_V
#undef PG8_WAIT_L
#undef PG8_BAR
#undef PG8_SCHED
}

struct EpiInProj {
    static constexpr bool PERM = true, AFTER_DRAIN = false;
    unsigned char* ws;
    __device__ __forceinline__ void operator()(const f32x4 (&acc)[2][2][4][2], const Unit& u, int wr, int wc, int fr, int fq) const {
        const int pn = u.pn, c8 = wc * 32 + 8 * fq;
#pragma unroll
        for (int ai = 0; ai < 2; ++ai)
#pragma unroll
            for (int m = 0; m < 4; ++m) {
                const int row = u.pm * BM + ai * HALF + wr * 64 + m * 16 + fr;
                if (pn < 5) {
                    size_t off0, bjstep;
                    if (pn < 2) { off0 = 134217728ull   + ((size_t)row * NSA_W + pn * 256 + c8) * 2; bjstep = HALF * 2; }
                    else { const int b = row >> 11, t = row & 2047, gg = c8 >> 6, d = c8 & 63;
                        off0 = 167772160ull   + (size_t)((pn - 2) * 2) * 5242880ull + (((size_t)((b * 2 + gg) * SEQ + t)) * HD + d) * 2; bjstep = 5242880ull; }
#pragma unroll
                    for (int bj = 0; bj < 2; ++bj) { const f32x4 v0 = acc[ai][bj][m][0], v1 = acc[ai][bj][m][1];
                        u32x4 w; w.x = pkh(v0[0], v0[1]); w.y = pkh(v0[2], v0[3]); w.z = pkh(v1[0], v1[1]); w.w = pkh(v1[2], v1[3]);
                        *(u32x4*)(ws + off0 + bj * bjstep) = w; }
                } else if (pn < 9) {
                    float o[8];
#pragma unroll
                    for (int n = 0; n < 2; ++n)
#pragma unroll
                        for (int j = 0; j < 4; ++j) o[n * 4 + j] = acc[ai][0][m][n][j] * sigmoidf_(acc[ai][1][m][n][j]);
                    u32x4 w; w.x = pkh(o[0], o[1]); w.y = pkh(o[2], o[3]); w.z = pkh(o[4], o[5]); w.w = pkh(o[6], o[7]);
                    *(u32x4*)(ws + 150994944ull   + ((size_t)row * CONV_CH + (pn - 5) * HALF + c8) * 2) = w;
                } else {
                    if (wc == 0 && fq < 3) {
#pragma unroll
                        for (int n = 0; n < 2; ++n) { f32x4 v = acc[ai][0][m][n]; f32x4 s; s[0] = sigmoidf_(v[0]); s[1] = sigmoidf_(v[1]); s[2] = sigmoidf_(v[2]); s[3] = sigmoidf_(v[3]);
                            *(f32x4*)(ws + 31457280ull   + ((size_t)row * 24 + 8 * fq + 4 * n) * 4) = s; }
                    }
                }
            }
    }
};
struct EpiF32 {
    static constexpr bool PERM = false, AFTER_DRAIN = false;
    float* C; int ldc;
    __device__ __forceinline__ void operator()(const f32x4 (&acc)[2][2][4][2], const Unit& u, int wr, int wc, int fr, int fq) const {
        const int row0 = u.pm * BM + wr * 64 + fr, col0 = u.pn * BM + wc * 32 + 4 * fq;
#pragma unroll
        for (int ai = 0; ai < 2; ++ai)
#pragma unroll
            for (int m = 0; m < 4; ++m) { float* rowp = C + (size_t)(row0 + ai * HALF + m * 16) * ldc + col0;
#pragma unroll
                for (int bj = 0; bj < 2; ++bj)
#pragma unroll
                    for (int n = 0; n < 2; ++n) *(f32x4*)(rowp + bj * HALF + n * 16) = acc[ai][bj][m][n]; }
    }
};
struct EpiF32W {
    static constexpr bool PERM = false, AFTER_DRAIN = false;
    unsigned char* ws; unsigned off; int ldc;
    __device__ __forceinline__ void operator()(const f32x4 (&acc)[2][2][4][2], const Unit& u, int wr, int wc, int fr, int fq) const {
        const __amdgpu_buffer_rsrc_t rs = __builtin_amdgcn_make_buffer_rsrc(ws, 0, 0x10000000, 0x00020000);
        const int row0 = u.pm * BM + wr * 64 + fr, col0 = u.pn * BM + wc * 32 + 4 * fq;
#pragma unroll
        for (int ai = 0; ai < 2; ++ai)
#pragma unroll
            for (int m = 0; m < 4; ++m) { const unsigned ro = off + (unsigned)((row0 + ai * HALF + m * 16) * ldc + col0) * 4u;
#pragma unroll
                for (int bj = 0; bj < 2; ++bj)
#pragma unroll
                    for (int n = 0; n < 2; ++n) __builtin_amdgcn_raw_buffer_store_b128(__builtin_bit_cast(u32x4, acc[ai][bj][m][n]), rs, ro + (unsigned)(bj * HALF + n * 16) * 4u, 0, 16); }
    }
};
struct EpiOutProj {
    static constexpr bool PERM = false, AFTER_DRAIN = true;
    const float* x; half_t* H1H; float* SSQ;
    __device__ __forceinline__ void fused(f32x4 (&acc)[2][2][4][2], const Unit& u, int wr, int wc, int fr, int fq, LAS unsigned char* lds, int wid, int lane) const {
        LAS float* P = (LAS float*)lds;
        const int col0 = u.pn * BM + wc * 32 + 4 * fq;
#pragma unroll
        for (int ai = 0; ai < 2; ++ai)
#pragma unroll
            for (int m = 0; m < 4; ++m) {
                const int rl = ai * HALF + wr * 64 + m * 16 + fr; const size_t off = (size_t)(u.pm * BM + rl) * D_MODEL + col0; float ss = 0.f;
#pragma unroll
                for (int bj = 0; bj < 2; ++bj)
#pragma unroll
                    for (int n = 0; n < 2; ++n) { const f32x4 xv = *(const f32x4*)(x + off + bj * HALF + n * 16); const f32x4 h = xv + acc[ai][bj][m][n];
                        u32x2 w; if (FFN_BF16) { w.x = pkb(h[0], h[1]); w.y = pkb(h[2], h[3]); } else { w.x = pkh(h[0], h[1]); w.y = pkh(h[2], h[3]); } *(u32x2*)(H1H + off + bj * HALF + n * 16) = w;
                        ss += (h[0] * h[0] + h[1] * h[1]) + (h[2] * h[2] + h[3] * h[3]); }
                ss += __shfl_xor(ss, 16); ss += __shfl_xor(ss, 32);
                if (fq == 0) P[rl * 4 + wc] = ss;
            }
        asm volatile("s_waitcnt lgkmcnt(0)" ::: "memory"); __builtin_amdgcn_s_barrier(); asm volatile("" ::: "memory");
        const int tid = wid * 64 + lane;
        if (tid < 256) { const float s = (P[tid * 4 + 0] + P[tid * 4 + 1]) + (P[tid * 4 + 2] + P[tid * 4 + 3]); SSQ[(size_t)(u.pm * BM + tid) * 4 + u.pn] = s; }
        asm volatile("s_waitcnt lgkmcnt(0)" ::: "memory"); __builtin_amdgcn_s_barrier(); asm volatile("" ::: "memory");
    }
};
struct EpiGateUp {
    static constexpr bool PERM = true, AFTER_DRAIN = false;
    const LAS float* RT; unsigned char* ws; bool half;
    __device__ __forceinline__ void operator()(const f32x4 (&acc)[2][2][4][2], const Unit& u, int wr, int wc, int fr, int fq) const {
        const int c8 = wc * 32 + 8 * fq;
        const __amdgpu_buffer_rsrc_t rs = __builtin_amdgcn_make_buffer_rsrc(ws, 0, 0x10000000, 0x00020000);
#pragma unroll
        for (int ai = 0; ai < 2; ++ai)
#pragma unroll
            for (int m = 0; m < 4; ++m) {
                if (half && ai == 1) continue;
                const int rl = (half ? u.hh : ai) * HALF + wr * 64 + m * 16 + fr, row = u.pm * BM + rl;
                const float r = RT[(u.pm & 7) * BM + rl];
                float o[8];
#pragma unroll
                for (int n = 0; n < 2; ++n)
#pragma unroll
                    for (int j = 0; j < 4; ++j) { const float gv = acc[ai][0][m][n][j] * r, uv = acc[ai][1][m][n][j] * r; o[n * 4 + j] = gv * sigmoidf_(gv) * uv; }
                u32x4 w; if (FFN_BF16) { w.x = pkb(o[0], o[1]); w.y = pkb(o[2], o[3]); w.z = pkb(o[4], o[5]); w.w = pkb(o[6], o[7]); } else { w.x = pkh(o[0], o[1]); w.y = pkh(o[2], o[3]); w.z = pkh(o[4], o[5]); w.w = pkh(o[6], o[7]); }
                __builtin_amdgcn_raw_buffer_store_b128(w, rs, (unsigned)(100663296u + ((unsigned)row * FFN + u.pn * HALF + c8) * 2u), 0, 16);
            }
    }
};
struct EpiDown {
    static constexpr bool PERM = false, AFTER_DRAIN = false;
    const half_t* H1H; float* out;
    __device__ __forceinline__ void operator()(const f32x4 (&acc)[2][2][4][2], const Unit& u, int wr, int wc, int fr, int fq) const {
        const int row0 = u.pm * BM + wr * 64 + fr, col0 = u.pn * BM + wc * 32 + 4 * fq;
#pragma unroll
        for (int ai = 0; ai < 2; ++ai)
#pragma unroll
            for (int m = 0; m < 4; ++m) { const size_t off = (size_t)(row0 + ai * HALF + m * 16) * D_MODEL + col0;
#pragma unroll
                for (int bj = 0; bj < 2; ++bj)
#pragma unroll
                    for (int n = 0; n < 2; ++n) { const u32x2 hh = *(const u32x2*)(H1H + off + bj * HALF + n * 16); f32x4 h;
                        if (FFN_BF16) { h[0] = __uint_as_float(hh.x << 16); h[1] = __uint_as_float(hh.x & 0xffff0000u); h[2] = __uint_as_float(hh.y << 16); h[3] = __uint_as_float(hh.y & 0xffff0000u); }
                        else { const h4 q = __builtin_bit_cast(h4, hh); h[0] = (float)q[0]; h[1] = (float)q[1]; h[2] = (float)q[2]; h[3] = (float)q[3]; }
                        *(f32x4*)(out + off + bj * HALF + n * 16) = h + acc[ai][bj][m][n]; } }
    }
};
}

constexpr int NWAVES = 8;
constexpr int N_PHASES = 8;
constexpr size_t MiB = 1u << 20;
constexpr size_t WS_CTL = 0, CTL_ZERO_BYTES = 128 * 1024;
constexpr size_t WS_BIASP = 1 * MiB;
constexpr size_t WS_ROPEC = 1 * MiB + 64 * 1024;
constexpr size_t WS_ROPES = WS_ROPEC + 256 * 1024;
constexpr size_t WS_SSQ = WS_ROPES + 256 * 1024;
constexpr size_t WS_GMAX = 1 * MiB + 32 * 1024;
constexpr size_t WS_W1K = 3 * MiB, WS_W1V = 4 * MiB;
constexpr size_t WS_WIN = 5 * MiB;
constexpr size_t WS_WOUT = 10 * MiB;
constexpr size_t WS_WGU = 12 * MiB;
constexpr size_t WS_WDN = 23 * MiB;
constexpr size_t WS_KCMP = 29 * MiB, WS_VCMP = 29 * MiB + 256 * 1024;
constexpr size_t WS_GATES = 30 * MiB;
constexpr size_t WS_H1H = 32 * MiB;
constexpr size_t WS_MIX = 64 * MiB;
constexpr size_t WS_HB = 96 * MiB;
constexpr size_t WS_XN = 96 * MiB;
constexpr size_t WS_Q = 128 * MiB;
constexpr size_t WS_HCV = 144 * MiB;
constexpr size_t WS_KV6 = 160 * MiB, KV6_STRIDE = 5 * MiB;
constexpr size_t WS_KC = WS_KV6, WS_VC = WS_KV6 + KV6_STRIDE, WS_KSR = WS_KV6 + 2 * KV6_STRIDE, WS_VS = WS_KV6 + 3 * KV6_STRIDE, WS_KWR = WS_KV6 + 4 * KV6_STRIDE, WS_VW = WS_KV6 + 5 * KV6_STRIDE;
constexpr size_t WS_HIDP = 96 * MiB;
constexpr size_t WS_KS = 200 * MiB, WS_KW = 204 * MiB;
constexpr size_t WS_END = 208 * MiB;
static_assert(WS_HB == 100663296ull, "EpiGateUp literal offset");
static_assert(WS_Q == 134217728ull && WS_KV6 == 167772160ull && KV6_STRIDE == 5242880ull && WS_HCV == 150994944ull && WS_GATES == 31457280ull, "EpiInProj literal offsets");
constexpr int CW_BAR = 1024;

constexpr int RING_BYTES = 131072;
constexpr int LDSCTL_OFF = 147456, MISC_OFF = LDSCTL_OFF + 320;
constexpr int LDS_BYTES = 147456 + 1024;

typedef GAS unsigned gu32;
#define RLX_AGENT __ATOMIC_RELAXED, __HIP_MEMORY_SCOPE_AGENT

#define XB_TMO      128
#define XB_XCNT(j)  (256  + 64 * (j))
#define XB_XSUB(j)  (1280 + 64 * (j))
#define XB_XGEN(j)  (2304 + 64 * (j))
#define XB_TOP      3328
#define XB_TOPGEN   3392
#define XCD_BAR_WORDS 3456
#define XB_SPIN_CAP (1u << 22)
__device__ __forceinline__ unsigned xb_ld(unsigned* p)              { return __hip_atomic_load(p, __ATOMIC_RELAXED, __HIP_MEMORY_SCOPE_AGENT); }
__device__ __forceinline__ unsigned xb_add(unsigned* p, unsigned v) { return __hip_atomic_fetch_add(p, v, __ATOMIC_RELAXED, __HIP_MEMORY_SCOPE_AGENT); }
__device__ __forceinline__ unsigned xb_xcc_id() { return (unsigned)__builtin_amdgcn_s_getreg((3 << 11) | 20) & 0xFu; }
#define XB_SPIN(cond, bar) do { unsigned _sp = 0; while (cond) { __builtin_amdgcn_s_sleep(1); \
    if ((++_sp & 255u) == 0u) { if (xb_ld(&(bar)[XB_TMO])) break; if (_sp > XB_SPIN_CAP) { atomicAdd(&(bar)[XB_TMO], 1u); break; } } } } while (0)
struct XcdBarrier { unsigned* bar; unsigned x; volatile LAS unsigned* st; };
__device__ __forceinline__ XcdBarrier xcd_barrier_post(unsigned* bar, volatile LAS unsigned* st) {
    XcdBarrier b; b.bar = bar; b.x = xb_xcc_id(); b.st = st;
    if (threadIdx.x == 0) (void)xb_add(&bar[XB_XCNT(b.x)], 1u);
    return b;
}
__device__ __forceinline__ void xcd_barrier_complete(unsigned* bar, unsigned x, unsigned& nloc, unsigned& nx) {
    const unsigned G = gridDim.x * gridDim.y * gridDim.z;
    unsigned sum, cnt, mine, sp = 0u;
    for (;;) {
        sum = 0u; cnt = 0u; mine = 0u;
#pragma unroll
        for (unsigned j = 0; j < 16; ++j) { const unsigned c = xb_ld(&bar[XB_XCNT(j)]); sum += c; cnt += (c > 0u) ? 1u : 0u; mine = (j == x) ? c : mine; }
        if (sum == G) break;
        __builtin_amdgcn_s_sleep(1);
        if ((++sp & 255u) == 0u) { if (xb_ld(&bar[XB_TMO])) break; if (sp > XB_SPIN_CAP) { atomicAdd(&bar[XB_TMO], 1u); break; } }
    }
    nloc = mine > 0u ? mine : 1u; nx = cnt > 0u ? cnt : 1u;
}
__device__ __forceinline__ void xcd_barrier(const XcdBarrier& b) {
    asm volatile("s_waitcnt vmcnt(0)" ::: "memory");
    __syncthreads();
    if (threadIdx.x == 0) {
        unsigned* bar = b.bar;
        __builtin_amdgcn_s_waitcnt(0);
        unsigned nloc = b.st[0], nx = b.st[1];
        if (nloc == 0u) { xcd_barrier_complete(bar, b.x, nloc, nx); b.st[0] = nloc; b.st[1] = nx; }
        const unsigned old = xb_add(&bar[XB_XSUB(b.x)], 1u);
        const unsigned gen = old / nloc;
        if (old + 1u == (gen + 1u) * nloc) {
            __builtin_amdgcn_fence(__ATOMIC_RELEASE, "agent");
            asm volatile("s_waitcnt vmcnt(0)" ::: "memory");
            const unsigned og = xb_add(&bar[XB_TOP], 1u);
            const unsigned tg = og / nx;
            if (og + 1u == (tg + 1u) * nx) xb_add(&bar[XB_TOPGEN], 1u);
            else XB_SPIN(xb_ld(&bar[XB_TOPGEN]) == tg, bar);
            __builtin_amdgcn_fence(__ATOMIC_ACQUIRE, "agent");
            xb_add(&bar[XB_XGEN(b.x)], 1u);
            asm volatile("s_waitcnt vmcnt(0)" ::: "memory");
        } else {
            XB_SPIN(xb_ld(&bar[XB_XGEN(b.x)]) == gen, bar);
            __builtin_amdgcn_fence(__ATOMIC_ACQUIRE, "agent");
            asm volatile("s_waitcnt vmcnt(0)" ::: "memory");
        }
    }
    __syncthreads();
}

struct Args { const float* in[23]; float* out; unsigned char* ws; int ph_lo, ph_hi, li, pad; };

struct Frame {
    LAS unsigned char* lds;
    int tid, lane, wave, vcu, G;
    unsigned char* ws;
};

__device__ __forceinline__ int map_col(int mode, int n) {
    if (mode == 0) return n;
    if (mode == 1) {
        if (n < 1280) return n;
        if (n < 1304) return 2304 + (n - 1280);
        if (n < 1816) { const int c = n - 1304; return 1280 + (c >> 7) * 256 + (c & 127); }
        const int c = n - 1816; return 1280 + (c >> 7) * 256 + 128 + (c & 127);
    }
    if (n < FFN) return (n >> 7) * 256 + (n & 127);
    const int c = n - FFN; return (c >> 7) * 256 + 128 + (c & 127);
}
constexpr int TR_SCR = 64 * 65 * 4;
template <bool BF = false>
__device__ __forceinline__ void p0_transpose_item(const float* W, int K, int N, half_t* WT, int mode, const float* sc, LAS float* scr, int item, int lane) {
    const int nblk = (N + 63) / 64, kb = item / nblk, nb = item % nblk, k0 = 64 * kb, n0 = 64 * nb;
    const int nn = n0 + (lane & 15) * 4; const bool nok = nn < N;
    f32x4 v[16];
#pragma unroll
    for (int i = 0; i < 16; ++i) { const int kk = 4 * i + (lane >> 4); v[i] = nok ? *(const f32x4*)(W + (size_t)(k0 + kk) * N + nn) : (f32x4){0.f, 0.f, 0.f, 0.f}; if (sc) v[i] *= sc[k0 + kk]; }
#pragma unroll
    for (int i = 0; i < 16; ++i) { const int kk = 4 * i + (lane >> 4); LAS float* d = scr + kk * 65 + (lane & 15) * 4; d[0] = v[i][0]; d[1] = v[i][1]; d[2] = v[i][2]; d[3] = v[i][3]; }
    asm volatile("s_waitcnt lgkmcnt(0)" ::: "memory");
    const int c = lane & 7;
#pragma unroll
    for (int j = 0; j < 8; ++j) { const int n = (lane >> 3) + 8 * j; const LAS float* s = scr + (8 * c) * 65 + n;
        u32x4 o; if (BF) { o.x = pkb(s[0 * 65], s[1 * 65]); o.y = pkb(s[2 * 65], s[3 * 65]); o.z = pkb(s[4 * 65], s[5 * 65]); o.w = pkb(s[6 * 65], s[7 * 65]); }
        else { o.x = pkh(s[0 * 65], s[1 * 65]); o.y = pkh(s[2 * 65], s[3 * 65]); o.z = pkh(s[4 * 65], s[5 * 65]); o.w = pkh(s[6 * 65], s[7 * 65]); }
        if (n0 + n < N) *(u32x4*)(WT + (size_t)map_col(mode, n0 + n) * K + k0 + 8 * c) = o; }
    asm volatile("s_waitcnt lgkmcnt(0)" ::: "memory");
}
__device__ __forceinline__ void p0_prologue(Frame& F, const Args& a) {
    LAS float* scr = (LAS float*)(F.lds + F.wave * TR_SCR);
    const int gw = F.vcu * NWAVES + F.wave, NGW = F.G * NWAVES, lane = F.lane;
    const float* w_in = a.in[2]; const float* w1k = a.in[8]; const float* w1v = a.in[11];
    constexpr int I_IN = 16 * 37, I_W1 = 32 * 4;
    constexpr int NITEMS = I_IN + 2 * I_W1;
    for (int it = gw; it < NITEMS; it += NGW) {
        int r = it;
        if (r < I_IN) { p0_transpose_item<IN_BF16 != 0>(w_in, 1024, IN_W, (half_t*)(F.ws + WS_WIN), 1, nullptr, scr, r, lane); continue; } r -= I_IN;
        if (r < I_W1) { p0_transpose_item(w1k, 2048, 256, (half_t*)(F.ws + WS_W1K), 0, nullptr, scr, r, lane); continue; } r -= I_W1;
        p0_transpose_item(w1v, 2048, 256, (half_t*)(F.ws + WS_W1V), 0, nullptr, scr, r, lane);
    }
    {
        const float* x = a.in[0]; const float* g = a.in[1]; half_t* XN = (half_t*)(F.ws + WS_XN);
        f32x4 gv[4];
#pragma unroll
        for (int j = 0; j < 4; ++j) gv[j] = *(const f32x4*)(g + 4 * lane + 256 * j);
        for (int m = gw; m < M; m += 2 * NGW) {
            const int m2 = m + NGW;
            const f32x4* xr = (const f32x4*)(x + (size_t)m * D_MODEL) + lane; const f32x4* xr2 = (const f32x4*)(x + (size_t)m2 * D_MODEL) + lane; f32x4 v[4], w[4]; float s = 0.f, s2 = 0.f;
#pragma unroll
            for (int j = 0; j < 4; ++j) { v[j] = xr[64 * j]; w[j] = xr2[64 * j]; }
#pragma unroll
            for (int j = 0; j < 4; ++j) { s += (v[j][0] * v[j][0] + v[j][1] * v[j][1]) + (v[j][2] * v[j][2] + v[j][3] * v[j][3]); s2 += (w[j][0] * w[j][0] + w[j][1] * w[j][1]) + (w[j][2] * w[j][2] + w[j][3] * w[j][3]); }
            const float r = 1.0f / sqrtf(wave_sum(s) * (1.0f / D_MODEL) + EPS), r2 = 1.0f / sqrtf(wave_sum(s2) * (1.0f / D_MODEL) + EPS);
            u32x2* o8 = (u32x2*)(XN + (size_t)m * D_MODEL) + lane; u32x2* o82 = (u32x2*)(XN + (size_t)m2 * D_MODEL) + lane;
#pragma unroll
            for (int j = 0; j < 4; ++j) { u32x2 t; t.x = PKI(v[j][0] * r * gv[j][0], v[j][1] * r * gv[j][1]); t.y = PKI(v[j][2] * r * gv[j][2], v[j][3] * r * gv[j][3]); o8[64 * j] = t;
                u32x2 t2; t2.x = PKI(w[j][0] * r2 * gv[j][0], w[j][1] * r2 * gv[j][1]); t2.y = PKI(w[j][2] * r2 * gv[j][2], w[j][3] * r2 * gv[j][3]); o82[64 * j] = t2; }
        }
    }
    {
        float* RC = (float*)(F.ws + WS_ROPEC); float* RS = (float*)(F.ws + WS_ROPES);
        for (int e = gw * 64 + lane; e < SEQ * 32; e += NGW * 64) { const int pos = e >> 5, i = e & 31;
            const float inv = exp2f(-(float)i * (13.287712379549449f / 32.0f)); const float ang = (float)pos * inv; float sn, cs; sincosf(ang, &sn, &cs); RC[e] = cs; RS[e] = sn; }
    }
    if (gw == 0) { float gs = fabsf(a.in[5][lane]), gw_ = fabsf(a.in[6][lane]);
#pragma unroll
        for (int o = 1; o < 64; o <<= 1) { gs = fmaxf(gs, __shfl_xor(gs, o)); gw_ = fmaxf(gw_, __shfl_xor(gw_, o)); }
        if (lane == 0) { float* GM = (float*)(F.ws + WS_GMAX); GM[0] = gs; GM[1] = gw_; } }
    {
        float* BP = (float*)(F.ws + WS_BIASP);
        for (int it = gw; it < 16 * 2 * 4; it += NGW) { const int seg = it >> 3, kv = (it >> 2) & 1, jb = it & 3, j = jb * 64 + lane;
            const float* pe = kv ? a.in[10] : a.in[7]; const float* w1 = kv ? a.in[11] : a.in[8]; float s = 0.f;
            for (int r = seg * 128; r < seg * 128 + 128; ++r) s += pe[r] * w1[(size_t)r * CMP_HID + j];
            BP[(seg * 2 + kv) * CMP_HID + j] = s; }
    }
}

__device__ __forceinline__ void late_weights(Frame& F, const Args& a, int wi, int nw, int lo, int hi) {
    LAS float* scr = (LAS float*)(F.lds + F.wave * TR_SCR);
    const float* w_out = a.in[19]; const float* w_gu = a.in[21]; const float* w_dn = a.in[22];
    constexpr int I_OUT = 16 * 16, I_GU = 16 * 88, I_DN = 44 * 16;
    if (hi > I_OUT + I_GU + I_DN) hi = I_OUT + I_GU + I_DN;
    for (int it = lo + wi; it < hi; it += nw) {
        int r = it;
        if (r < I_OUT) { p0_transpose_item<MIX_BF16 != 0>(w_out, 1024, 1024, (half_t*)(F.ws + WS_WOUT), 0, nullptr, scr, r, F.lane); continue; } r -= I_OUT;
        if (r < I_GU) { p0_transpose_item<FFN_BF16 != 0>(w_gu, 1024, 2 * FFN, (half_t*)(F.ws + WS_WGU), 2, a.in[20], scr, r, F.lane); continue; } r -= I_GU;
        p0_transpose_item<FFN_BF16 != 0>(w_dn, FFN, 1024, (half_t*)(F.ws + WS_WDN), 0, nullptr, scr, r, F.lane);
    }
}
__device__ __forceinline__ void conv_half(Frame& F, const Args& a, int hidx) {
    const int item = hidx >> 1, jh = hidx & 1;
    const int c = F.tid, r0 = item * 64, b = r0 >> 11, tl0 = r0 & 2047, lane = F.lane;
    const half_t* HCV = (const half_t*)(F.ws + WS_HCV); half_t* MIX = (half_t*)(F.ws + WS_MIX);
    const float* cw = a.in[13];
    LAS half_t* X = (LAS half_t*)F.lds;
    LAS float* Y = (LAS float*)(F.lds + 65536);
    float w[31];
#pragma unroll
    for (int k = 0; k < 31; ++k) w[k] = cw[k * CONV_CH + c];
    const float bias = a.in[14][c];
    const float* lg = a.in[15]; const float* lb = a.in[16]; const float* og = a.in[18];
    float g8[8], b8[8], o8[8];
#pragma unroll
    for (int i = 0; i < 8; ++i) { g8[i] = lg[lane * 8 + i]; b8[i] = lb[lane * 8 + i]; o8[i] = og[lane * 8 + i]; }
    {
        u32x4 st[8];
#pragma unroll
        for (int k = 0; k < 8; ++k) { const int id = c + 512 * k, rr = id >> 6, cc = id & 63, tl = tl0 - 30 + 32 * jh + rr;
            st[k] = (rr < 62 && tl >= 0) ? *(const u32x4*)(HCV + (size_t)(b * SEQ + tl) * CONV_CH + cc * 8) : (u32x4){0u, 0u, 0u, 0u}; }
#pragma unroll
        for (int k = 0; k < 8; ++k) { const int id = c + 512 * k; if ((id >> 6) < 62) *(LAS u32x4*)(X + id * 8) = st[k]; }
        __syncthreads();
        float x[62];
#pragma unroll
        for (int i = 0; i < 62; ++i) x[i] = (float)X[i * CONV_CH + c];
#pragma unroll
        for (int j = 0; j < 32; ++j) { float y = bias;
#pragma unroll
            for (int k = 0; k < 31; ++k) y = __builtin_fmaf(w[k], x[j + k], y);
            Y[j * CONV_CH + c] = y; }
        __syncthreads();
#pragma unroll 1
        for (int jj = 0; jj < 4; ++jj) { const int j = F.wave * 4 + jj; float v[8];
            const f32x4 va = *(const LAS f32x4*)(Y + j * CONV_CH + lane * 8), vb = *(const LAS f32x4*)(Y + j * CONV_CH + lane * 8 + 4);
            v[0] = va[0]; v[1] = va[1]; v[2] = va[2]; v[3] = va[3]; v[4] = vb[0]; v[5] = vb[1]; v[6] = vb[2]; v[7] = vb[3];
            float s = 0.f;
#pragma unroll
            for (int i = 0; i < 8; ++i) s += v[i];
            const float mean = wave_sum(s) * (1.0f / CONV_CH); float q = 0.f;
#pragma unroll
            for (int i = 0; i < 8; ++i) { v[i] -= mean; q += v[i] * v[i]; }
            const float rstd = 1.0f / sqrtf(wave_sum(q) * (1.0f / CONV_CH) + EPS); float ss = 0.f;
#pragma unroll
            for (int i = 0; i < 8; ++i) { const float hn = v[i] * rstd * g8[i] + b8[i]; const float sl = hn * sigmoidf_(hn); v[i] = sl; ss += sl * sl; }
            const float r2 = 1.0f / sqrtf(wave_sum(ss) * (1.0f / CONV_CH) + EPS);
            u32x4 wv; wv.x = PKM(v[0] * r2 * o8[0], v[1] * r2 * o8[1]); wv.y = PKM(v[2] * r2 * o8[2], v[3] * r2 * o8[3]); wv.z = PKM(v[4] * r2 * o8[4], v[5] * r2 * o8[5]); wv.w = PKM(v[6] * r2 * o8[6], v[7] * r2 * o8[7]);
            *(u32x4*)(MIX + (size_t)(r0 + 32 * jh + j) * D_MODEL + NSA_W + lane * 8) = wv; }
        __syncthreads();
    }
}
__device__ __forceinline__ void conv_item(Frame& F, const Args& a, int item) { conv_half(F, a, 2 * item); conv_half(F, a, 2 * item + 1); }
__device__ __forceinline__ void kprep(Frame& F, const Args& a) {
    const int gw = F.vcu * NWAVES + F.wave, NGW = F.G * NWAVES, lane = F.lane, l8 = lane & 7, sub = lane >> 3;
    const float* RC = (const float*)(F.ws + WS_ROPEC); const float* RS = (const float*)(F.ws + WS_ROPES);
    constexpr int NROWB = (2 * BATCH * NG * SEQ) / 8;
    for (int rb = gw; rb < NROWB; rb += NGW) {
        const int rowg = rb * 8 + sub; const int which = rowg >= BATCH * NG * SEQ; const int row = rowg - which * BATCH * NG * SEQ; const int t = row & 2047;
        const half_t* src = (const half_t*)(F.ws + (which ? WS_KWR : WS_KSR)) + (size_t)row * HD; half_t* dst = (half_t*)(F.ws + (which ? WS_KW : WS_KS)) + (size_t)row * HD;
        const float* gn = which ? a.in[6] : a.in[5];
        const h4 r1 = *(const h4*)(src + 4 * l8), r2 = *(const h4*)(src + 32 + 4 * l8);
        float v1[4], v2[4]; float ss = 0.f;
#pragma unroll
        for (int i = 0; i < 4; ++i) { v1[i] = (float)r1[i]; v2[i] = (float)r2[i]; ss += v1[i] * v1[i] + v2[i] * v2[i]; }
        ss += __shfl_xor(ss, 1); ss += __shfl_xor(ss, 2); ss += __shfl_xor(ss, 4);
        const float r = 1.0f / sqrtf(ss * (1.0f / HD) + EPS);
        const f32x4 cs = *(const f32x4*)(RC + t * 32 + 4 * l8), sn = *(const f32x4*)(RS + t * 32 + 4 * l8);
        float o1[4], o2[4];
#pragma unroll
        for (int i = 0; i < 4; ++i) { const float x1 = v1[i] * r * gn[4 * l8 + i], x2 = v2[i] * r * gn[32 + 4 * l8 + i]; o1[i] = x1 * cs[i] - x2 * sn[i]; o2[i] = x2 * cs[i] + x1 * sn[i]; }
        u32x2 w1; w1.x = pkh(o1[0], o1[1]); w1.y = pkh(o1[2], o1[3]); u32x2 w2; w2.x = pkh(o2[0], o2[1]); w2.y = pkh(o2[2], o2[3]);
        *(u32x2*)(dst + 4 * l8) = w1; *(u32x2*)(dst + 32 + 4 * l8) = w2;
    }
}
template <bool W2_LDS>
__device__ __forceinline__ void cmp_finalize(Frame& F, const Args& a, int it0, int its, int it1, int kv_wg) {
    const int lane = F.lane;
    const float* BP = (const float*)(F.ws + WS_BIASP); const float* HIDP = (const float*)(F.ws + WS_HIDP);
    const float* RC = (const float*)(F.ws + WS_ROPEC); const float* RS = (const float*)(F.ws + WS_ROPES);
    LAS float* W2L = (LAS float*)F.lds; constexpr bool w2_lds = W2_LDS;
    if (w2_lds) { const float* w2g = kv_wg ? a.in[12] : a.in[9];
#pragma unroll
        for (int k = 0; k < 8; ++k) { const int id = F.tid + 512 * k; *(LAS f32x4*)(W2L + id * 4) = *(const f32x4*)(w2g + id * 4); }
        __syncthreads(); }
    for (int it = it0; it < it1; it += its) {
        const int kv = it >> 10, row = (it & 1023) * 2, n = row & 127;
        f32x4 bias = {0.f, 0.f, 0.f, 0.f};
#pragma unroll
        for (int seg = 0; seg < 16; ++seg) bias += *(const f32x4*)(BP + (seg * 2 + kv) * CMP_HID + 4 * lane);
        f32x4 hv0 = bias, hv1 = bias;
#pragma unroll
        for (int ks = 0; ks < 8; ++ks) { const float* hp = HIDP + ((size_t)(kv * 8 + ks) * 2048 + row) * CMP_HID + 4 * lane; hv0 += *(const f32x4*)hp; hv1 += *(const f32x4*)(hp + CMP_HID); }
        float hs0[4], hs1[4];
#pragma unroll
        for (int i = 0; i < 4; ++i) { hs0[i] = hv0[i] * sigmoidf_(hv0[i]); hs1[i] = hv1[i] * sigmoidf_(hv1[i]); }
        const float* w2 = (kv ? a.in[12] : a.in[9]) + lane; float o0 = 0.f, o1 = 0.f;
#pragma unroll 2
        for (int jl = 0; jl < 64; ++jl) {
            float w[4];
#pragma unroll
            for (int i = 0; i < 4; ++i) w[i] = w2_lds ? W2L[(jl * 4 + i) * HD + lane] : w2[(jl * 4 + i) * HD];
#pragma unroll
            for (int i = 0; i < 4; ++i) { const float b0 = __int_as_float(__builtin_amdgcn_readlane(__float_as_int(hs0[i]), jl)), b1 = __int_as_float(__builtin_amdgcn_readlane(__float_as_int(hs1[i]), jl));
                o0 = __builtin_fmaf(b0, w[i], o0); o1 = __builtin_fmaf(b1, w[i], o1); }
        }
        half_t* dst = (half_t*)(F.ws + (kv ? WS_VCMP : WS_KCMP)) + (size_t)row * HD + lane;
        if (kv == 0) {
            const float gk = a.in[4][lane]; const int i = lane & 31;
            { const float r = 1.0f / sqrtf(wave_sum(o0 * o0) * (1.0f / HD) + EPS); const float xn = o0 * r * gk; const float other = __shfl_xor(xn, 32); const int pos = 16 * n + 31; const float cs = RC[pos * 32 + i], sn = RS[pos * 32 + i];
              o0 = lane < 32 ? xn * cs - other * sn : xn * cs + other * sn; }
            { const float r = 1.0f / sqrtf(wave_sum(o1 * o1) * (1.0f / HD) + EPS); const float xn = o1 * r * gk; const float other = __shfl_xor(xn, 32); const int pos = 16 * (n + 1) + 31; const float cs = RC[(pos & 2047) * 32 + i], sn = RS[(pos & 2047) * 32 + i];
              o1 = lane < 32 ? xn * cs - other * sn : xn * cs + other * sn; }
        }
        dst[0] = (half_t)o0;
        dst[HD] = (n + 1 == NCMP) ? (half_t)0.f : (half_t)o1;
    }
}

constexpr int A_CMPK = 0, A_CMPV = 32768, A_IMP = 65536, A_KS0 = 98304, A_KS1 = 114688, A_VS0 = 131072, A_VS1 = 65536, A_SSQ = 81920, A_OT = 0;
__device__ __forceinline__ int crow(int r, int hi) { return (r & 3) + 8 * (r >> 2) + 4 * hi; }
__device__ __forceinline__ s16x4 vtr(const LAS unsigned char* p) { return __builtin_bit_cast(s16x4, __builtin_amdgcn_ds_read_tr16_b64_v4i16((LAS s16x4*)p)); }
#define MFMA32(a, b, c) __builtin_amdgcn_mfma_f32_32x32x16_f16(a, b, c, 0, 0, 0)
__device__ __forceinline__ float xmax32(float v) { auto r = __builtin_amdgcn_permlane32_swap(__float_as_uint(v), __float_as_uint(v), false, false); return fmaxf(__uint_as_float(r[0]), __uint_as_float(r[1])); }
__device__ __forceinline__ float xsum32(float v) { auto r = __builtin_amdgcn_permlane32_swap(__float_as_uint(v), __float_as_uint(v), false, false); return __uint_as_float(r[0]) + __uint_as_float(r[1]); }
__device__ __forceinline__ float xget32(float v, int hi) { auto r = __builtin_amdgcn_permlane32_swap(__float_as_uint(v), __float_as_uint(v), false, false); return __uint_as_float(hi ? r[0] : r[1]); }

__device__ __forceinline__ f32x16 qk_lds(const LAS unsigned char* Kt, const h8 (&qf)[4], int r32, int hi) {
    f32x16 s = {};
    const LAS unsigned char* kp = Kt + r32 * 128; const int sw = (r32 >> 1) & 7;
#pragma unroll
    for (int d0 = 0; d0 < 4; ++d0) { const h8 kf = *(const LAS h8*)(kp + (((2 * d0 + hi) ^ sw) << 4)); s = MFMA32(kf, qf[d0], s); }
    return s;
}
__device__ __forceinline__ void pv_lds(f32x16 (&o)[2], const f32x16& p, const LAS unsigned char* Vt, int vb) {
#pragma unroll
    for (int s = 0; s < 2; ++s) {
        u32x4 pw; pw.x = pkh(p[8 * s + 0], p[8 * s + 1]); pw.y = pkh(p[8 * s + 2], p[8 * s + 3]); pw.z = pkh(p[8 * s + 4], p[8 * s + 5]); pw.w = pkh(p[8 * s + 6], p[8 * s + 7]);
        const h8 pf = __builtin_bit_cast(h8, pw);
#pragma unroll
        for (int dh = 0; dh < 2; ++dh) {
            const s16x4 lo = vtr(Vt + vb + dh * 2048 + s * 1024), hi4 = vtr(Vt + vb + dh * 2048 + s * 1024 + 512);
            const h8 vf = __builtin_bit_cast(h8, __builtin_shufflevector(lo, hi4, 0, 1, 2, 3, 4, 5, 6, 7));
            o[dh] = MFMA32(vf, pf, o[dh]);
        }
    }
}

__device__ __forceinline__ void attn_item(Frame& F, const Args& a, int b, int qt) {
    int tid = F.tid; asm volatile("" : "+v"(tid));
    const int lane = tid & 63, h = F.wave, g = h >> 2, r32 = lane & 31, hi = lane >> 5;
    const int t0 = qt * 32, t = t0 + r32, cur = qt >> 1;
    const size_t row = (size_t)b * SEQ + t;
    LAS unsigned char* lds = F.lds;
    LAS float* IMP = (LAS float*)(lds + A_IMP); LAS float* SSQ8 = (LAS float*)(lds + A_SSQ);
    const float* RC = (const float*)(F.ws + WS_ROPEC); const float* RS = (const float*)(F.ws + WS_ROPES);
    const int tg = tid >> 8, tkey = (tid >> 3) & 31, tc = tid & 7;
    const int kdst0 = tkey * 128 + ((tc ^ ((tkey >> 1) & 7)) << 4), vdst0 = (tc >> 2) * 2048 + tkey * 64 + (tc & 3) * 16;
    const int vb = (4 * hi + ((lane & 15) >> 2)) * 64 + ((lane >> 4) & 1) * 32 + (lane & 3) * 8;
    const int ntile = (qt >> 4) + 1;
    h8 qf[4]; f32x16 ot[2]; unsigned sel; u32x4 kr0, kr1, vr0, vr1, vq0, vq1; float m_s, m_w, qn2 = 0.f;
    const float* gt = (const float*)(F.ws + WS_GATES) + row * 24 + 3 * h;
    const float g_c = gt[0];
    const int n_s = cur + 1, kt0w = cur >= 8 ? cur - 8 : 0, nsteps = n_s + (cur - kt0w + 1);
    const unsigned kofb = (unsigned)((((b * 2 + tg) * SEQ + tkey) * HD + tc * 8) * 2);
#define ATT_TILE_BASE(wsoff_s, wsoff_w, i) (F.ws + ((i) < n_s ? (size_t)(wsoff_s) + (size_t)(i) * (64 * HD * 2) : (size_t)(wsoff_w) + (size_t)(kt0w + (i) - n_s) * (64 * HD * 2)))
#ifndef DUP_ATT_PRE
#define DUP_ATT_PRE 0
#endif
#pragma unroll 1
    for (int rep_ = 0; rep_ < (DUP_ATT_PRE ? 2 : 1); ++rep_) {
    {
        const size_t coff = ((size_t)((b * 2 + tg) * NCMP_PAD + tkey)) * HD + tc * 8;
        const half_t* Kc = (const half_t*)(F.ws + WS_KCMP) + coff; const half_t* Vc = (const half_t*)(F.ws + WS_VCMP) + coff;
        u32x4 kr[4], vr[4];
#pragma unroll
        for (int T = 0; T < 4; ++T) if (T < ntile) { kr[T] = *(const u32x4*)(Kc + T * 32 * HD); vr[T] = *(const u32x4*)(Vc + T * 32 * HD); }
#pragma unroll
        for (int T = 0; T < 4; ++T) if (T < ntile) { *(LAS u32x4*)(lds + A_CMPK + tg * 16384 + T * 4096 + kdst0) = kr[T]; *(LAS u32x4*)(lds + A_CMPV + tg * 16384 + T * 4096 + vdst0) = vr[T]; }
    }
    {
        const half_t* Qp = (const half_t*)(F.ws + WS_Q) + row * NSA_W + h * HD;
        float qv[4][8]; float ss = 0.f; qn2 = 0.f;
#pragma unroll
        for (int d0 = 0; d0 < 4; ++d0) { const h8 raw = *(const h8*)(Qp + 16 * d0 + 8 * hi);
#pragma unroll
            for (int j = 0; j < 8; ++j) { qv[d0][j] = (float)raw[j]; ss += qv[d0][j] * qv[d0][j]; } }
        ss = xsum32(ss);
        const float r = 1.0f / sqrtf(ss * (1.0f / HD) + EPS); const float* qg = a.in[3];
#pragma unroll
        for (int d0 = 0; d0 < 4; ++d0)
#pragma unroll
            for (int j = 0; j < 8; ++j) qv[d0][j] *= r * qg[16 * d0 + 8 * hi + j];
        const float sc = 0.125f * LOG2E;
#pragma unroll
        for (int d0 = 0; d0 < 2; ++d0) {
            float o1[8], o2[8];
#pragma unroll
            for (int j = 0; j < 8; ++j) { const int i = 16 * d0 + 8 * hi + j; const float cs = RC[t * 32 + i], sn = RS[t * 32 + i]; const float x1 = qv[d0][j], x2 = qv[d0 + 2][j];
                o1[j] = (x1 * cs - x2 * sn) * sc; o2[j] = (x2 * cs + x1 * sn) * sc; }
            u32x4 w1; w1.x = pkh(o1[0], o1[1]); w1.y = pkh(o1[2], o1[3]); w1.z = pkh(o1[4], o1[5]); w1.w = pkh(o1[6], o1[7]);
            u32x4 w2; w2.x = pkh(o2[0], o2[1]); w2.y = pkh(o2[2], o2[3]); w2.z = pkh(o2[4], o2[5]); w2.w = pkh(o2[6], o2[7]);
            qf[d0] = __builtin_bit_cast(h8, w1); qf[d0 + 2] = __builtin_bit_cast(h8, w2);
#pragma unroll
            for (int j = 0; j < 8; ++j) qn2 += o1[j] * o1[j] + o2[j] * o2[j];
        }
        qn2 = xsum32(qn2);
    }
    { const float qn = sqrtf(qn2) * 8.0f * 1.001f; const float* GM = (const float*)(F.ws + WS_GMAX); m_s = qn * GM[0] - 13.0f; m_w = qn * GM[1] - 13.0f; }
    { const unsigned char* k0p = ATT_TILE_BASE(WS_KS, WS_KW, 0); const unsigned char* k1p = ATT_TILE_BASE(WS_KS, WS_KW, 1);
      kr0 = *(const u32x4*)(k0p + kofb); kr1 = *(const u32x4*)(k0p + 4096 + kofb); vr0 = *(const u32x4*)(k1p + kofb); vr1 = *(const u32x4*)(k1p + 4096 + kofb);
      const unsigned char* v0p = ATT_TILE_BASE(WS_VS, WS_VW, 0); vq0 = *(const u32x4*)(v0p + kofb); vq1 = *(const u32x4*)(v0p + 4096 + kofb); }
    __syncthreads();
    {
        const LAS unsigned char* Kc = lds + A_CMPK + g * 16384; const LAS unsigned char* Vc = lds + A_CMPV + g * 16384;
        const int nmax = (t >= 31) ? ((t - 31) >> 4) : -1;
        float mx = -INFINITY;
#pragma unroll 1
        for (int T = 0; T < ntile; ++T) { f32x16 sc = qk_lds(Kc + T * 4096, qf, r32, hi);
#pragma unroll
            for (int r = 0; r < 16; ++r) { const int n = 32 * T + crow(r, hi); mx = fmaxf(mx, n > nmax ? -INFINITY : sc[r]); } }
        mx = xmax32(mx);
        const float mref = (nmax >= 0) ? mx : 0.f; float lsum = 0.f, carry = 0.f;
        f32x16 oc[2]; oc[0] = f32x16{}; oc[1] = f32x16{};
#pragma unroll 1
        for (int T = 0; T < ntile; ++T) { f32x16 pc = qk_lds(Kc + T * 4096, qf, r32, hi);
#pragma unroll
            for (int r = 0; r < 16; ++r) { const int n = 32 * T + crow(r, hi); pc[r] = __builtin_amdgcn_exp2f((n > nmax ? -INFINITY : pc[r]) - mref); lsum += pc[r]; }
            pv_lds(oc, pc, Vc + T * 4096, vb);
#pragma unroll
            for (int gq = 0; gq < 4; ++gq) {
                const float own = (pc[4 * gq] + pc[4 * gq + 1]) + (pc[4 * gq + 2] + 0.5f * pc[4 * gq + 3]);
                const float prevk3 = gq > 0 ? pc[gq > 0 ? 4 * gq - 1 : 0] : carry;
                const float recv = xget32(hi == 0 ? pc[4 * gq + 3] : prevk3, hi);
                IMP[(h * 32 + 8 * T + 2 * gq + hi) * 32 + r32] = own + 0.5f * recv;
            }
            carry = pc[15];
        }
        lsum = xsum32(lsum);
        const float inv = (nmax >= 0) ? 1.0f / lsum : 0.f;
#pragma unroll 1
        for (int T = 0; T < ntile; ++T)
#pragma unroll
            for (int gq = 0; gq < 4; ++gq) { LAS float* p = IMP + (h * 32 + 8 * T + 2 * gq + hi) * 32 + r32; *p = *p * inv; }
        const float gci = g_c * inv;
#pragma unroll
        for (int r = 0; r < 16; ++r) { ot[0][r] = gci * oc[0][r]; ot[1][r] = gci * oc[1][r]; }
        { LAS unsigned char* rb = lds + A_KS0 + tg * 8192; *(LAS u32x4*)(rb + kdst0) = kr0; *(LAS u32x4*)(rb + 4096 + kdst0) = kr1; *(LAS u32x4*)(rb + 16384 + kdst0) = vr0; *(LAS u32x4*)(rb + 16384 + 4096 + kdst0) = vr1;
          LAS unsigned char* vb0_ = lds + A_VS0 + tg * 8192; *(LAS u32x4*)(vb0_ + vdst0) = vq0; *(LAS u32x4*)(vb0_ + 4096 + vdst0) = vq1; }
        __syncthreads();
        if (cur + 1 <= 8) sel = (1u << (cur + 1)) - 1u;
        else {
            unsigned key[30];
#pragma unroll
            for (int j = 1; j < 30; ++j) { const LAS float* p = IMP + ((g * 4) * 32 + j) * 32 + r32; const float v = (p[0] + p[1024]) + (p[2048] + p[3072]);
                key[j] = (j <= cur - 2) ? ((__float_as_uint(v) & ~31u) | (unsigned)(31 - j)) : 0u; }
            sel = 1u | (1u << cur) | (1u << (cur - 1));
#pragma unroll 1
            for (int pass = 0; pass < 5; ++pass) { unsigned best = key[1];
#pragma unroll
                for (int j = 2; j < 30; ++j) best = best > key[j] ? best : key[j];
                sel |= 1u << (31u - (best & 31u));
#pragma unroll
                for (int j = 1; j < 30; ++j) key[j] = key[j] == best ? 0u : key[j]; }
        }
        __syncthreads();
    }
    }
    LAS unsigned char* OT = lds + A_OT + h * 8192 + lane * 16;
#pragma unroll
    for (int q = 0; q < 8; ++q) { f32x4 v; v[0] = ot[q >> 2][4 * (q & 3)]; v[1] = ot[q >> 2][4 * (q & 3) + 1]; v[2] = ot[q >> 2][4 * (q & 3) + 2]; v[3] = ot[q >> 2][4 * (q & 3) + 3]; *(LAS f32x4*)(OT + q * 1024) = v; }
    {
        float l_s = 0.f, l_w = 0.f; f32x16 o[2]; o[0] = f32x16{}; o[1] = f32x16{};
        u32x4 kra, krb, vra, vrb;
        const __amdgpu_buffer_rsrc_t wsrs = __builtin_amdgcn_make_buffer_rsrc(F.ws, 0, 0x10000000, 0x00020000);
#define ATT_TILE_OFF(wsoff_s, wsoff_w, i) ((unsigned)((i) < n_s ? (unsigned)(wsoff_s) + (unsigned)(i) * (64u * HD * 2) : (unsigned)(wsoff_w) + (unsigned)(kt0w + (i) - n_s) * (64u * HD * 2)))
#define ATT_ISSUE_K2(i, KA, KB) do { const unsigned so_ = ATT_TILE_OFF(WS_KS, WS_KW, i); KA = __builtin_amdgcn_raw_buffer_load_b128(wsrs, kofb, so_, 0); KB = __builtin_amdgcn_raw_buffer_load_b128(wsrs, kofb + 4096u, so_, 0); } while (0)
#define ATT_ISSUE_V2(i, VA, VB) do { const unsigned so_ = ATT_TILE_OFF(WS_VS, WS_VW, i); VA = __builtin_amdgcn_raw_buffer_load_b128(wsrs, kofb, so_, 0); VB = __builtin_amdgcn_raw_buffer_load_b128(wsrs, kofb + 4096u, so_, 0); } while (0)
        ATT_ISSUE_K2(2, kra, krb);
        ATT_ISSUE_V2(1, vra, vrb);
        f32x16 c0 = qk_lds(lds + A_KS0 + g * 8192, qf, r32, hi), c1 = qk_lds(lds + A_KS0 + g * 8192 + 4096, qf, r32, hi);
        asm volatile("s_waitcnt lgkmcnt(0)" ::: "memory"); __builtin_amdgcn_s_barrier(); asm volatile("" ::: "memory");
        f32x16 d0, d1;
        u32x4 pw0 = {0u, 0u, 0u, 0u}, pw1 = pw0, pw2 = pw0, pw3 = pw0;
        s16x4 vl[8], vh[8];
#pragma unroll
        for (int m_ = 0; m_ < 8; ++m_) { vl[m_] = (s16x4){0, 0, 0, 0}; vh[m_] = (s16x4){0, 0, 0, 0}; }
        LAS unsigned char* const kst_p = lds + A_KS0 + tg * 8192 + kdst0; const int vst_o = tg * 8192 + vdst0;
        const int vfr_o = g * 8192 + vb; int kfo[4];
#pragma unroll
        for (int d0_ = 0; d0_ < 4; ++d0_) kfo[d0_] = r32 * 128 + (((2 * d0_ + hi) ^ ((r32 >> 1) & 7)) << 4);
#define ATT_PIN(x) asm volatile("" : "+v"(x))
#define ATT_SB __builtin_amdgcn_sched_barrier(0)
#define ATT_VOFF(s_) ((s_) == 0 ? 0 : (s_) == 1 ? 1024 : (s_) == 2 ? 4096 : 5120)
#define ATT_VRD(m) do { vl[m] = vtr(vt_ + ((m) & 1) * 2048 + ATT_VOFF((m) >> 1)); vh[m] = vtr(vt_ + ((m) & 1) * 2048 + ATT_VOFF((m) >> 1) + 512); } while (0)
#define ATT_VF(m) __builtin_bit_cast(h8, __builtin_shufflevector(vl[m], vh[m], 0, 1, 2, 3, 4, 5, 6, 7))
#define ATT_KRD(m) do { kf[m] = *(const LAS h8*)(kt_ + ((m) & 1) * 4096 + kfo[(m) >> 1]); } while (0)
#define ATT_EX4(C, e) do { C[e] = __builtin_amdgcn_exp2f(C[e] - msub); C[(e) + 1] = __builtin_amdgcn_exp2f(C[(e) + 1] - msub); C[(e) + 2] = __builtin_amdgcn_exp2f(C[(e) + 2] - msub); C[(e) + 3] = __builtin_amdgcn_exp2f(C[(e) + 3] - msub); \
            rs += C[e]; rs += C[(e) + 1]; rs += C[(e) + 2]; rs += C[(e) + 3]; ATT_PIN(C); ATT_PIN(rs); } while (0)
#define ATT_PK4(C, e, WA, WB) do { WA = pkh(C[e], C[(e) + 1]); WB = pkh(C[(e) + 2], C[(e) + 3]); ATT_PIN(WA); ATT_PIN(WB); } while (0)
#define ATT_IT(j, C0, C1, N0, N1) do { \
            { LAS unsigned char* kb_ = kst_p + (((j) & 1) ? (A_KS1 - A_KS0) : 0); *(LAS u32x4*)(kb_) = kra; *(LAS u32x4*)(kb_ + 4096) = krb; }         \
            { LAS unsigned char* vb_ = lds + ((((j) + 1) & 1) ? A_VS1 : A_VS0) + vst_o; *(LAS u32x4*)(vb_) = vra; *(LAS u32x4*)(vb_ + 4096) = vrb; }      \
            ATT_ISSUE_K2((j) + 3, kra, krb); ATT_ISSUE_V2((j) + 2, vra, vrb);                    \
            const bool is_s_ = (j) < n_s; const int kt_i = is_s_ ? (j) : kt0w + (j) - n_s, kb_i = 64 * kt_i; \
            if (__builtin_expect(kt_i == cur || (!is_s_ && kt_i == cur - 8), 0)) { \
                _Pragma("unroll") for (int r = 0; r < 16; ++r) { const int key = kb_i + crow(r, hi); if (key > t || key <= t - 512) C0[r] = -INFINITY; if (key + 32 > t || key + 32 <= t - 512) C1[r] = -INFINITY; } } \
            const bool en_ = is_s_ ? ((sel >> kt_i) & 1u) : true; const float msub = en_ ? (is_s_ ? m_s : m_w) : INFINITY; float rs = 0.f; \
            const LAS unsigned char* vt_ = lds + (((j) & 1) ? A_VS1 : A_VS0) + vfr_o;                \
            const LAS unsigned char* kt_ = lds + ((((j) + 1) & 1) ? A_KS1 : A_KS0) + g * 8192;        \
            h8 kf[8]; \
            const h8 p0_ = __builtin_bit_cast(h8, pw0), p1_ = __builtin_bit_cast(h8, pw1), p2_ = __builtin_bit_cast(h8, pw2), p3_ = __builtin_bit_cast(h8, pw3); \
            ATT_SB; \
            o[0] = MFMA32(ATT_VF(0), p0_, o[0]); ATT_KRD(0); ATT_EX4(C0, 0); ATT_SB; \
            o[1] = MFMA32(ATT_VF(1), p0_, o[1]); ATT_KRD(1); ATT_EX4(C0, 4); ATT_SB; \
            o[0] = MFMA32(ATT_VF(2), p1_, o[0]); ATT_KRD(2); ATT_EX4(C0, 8); ATT_SB; \
            o[1] = MFMA32(ATT_VF(3), p1_, o[1]); ATT_KRD(3); ATT_EX4(C0, 12); ATT_SB; \
            o[0] = MFMA32(ATT_VF(4), p2_, o[0]); ATT_KRD(4); ATT_EX4(C1, 0); ATT_SB; \
            o[1] = MFMA32(ATT_VF(5), p2_, o[1]); ATT_KRD(5); ATT_EX4(C1, 4); ATT_SB; \
            o[0] = MFMA32(ATT_VF(6), p3_, o[0]); ATT_KRD(6); ATT_EX4(C1, 8); ATT_SB; \
            o[1] = MFMA32(ATT_VF(7), p3_, o[1]); ATT_KRD(7); ATT_EX4(C1, 12); ATT_SB; \
            N0 = MFMA32(kf[0], qf[0], (f32x16){}); ATT_VRD(0); ATT_PK4(C0, 0, pw0.x, pw0.y); ATT_SB; \
            N1 = MFMA32(kf[1], qf[0], (f32x16){}); ATT_VRD(1); ATT_PK4(C0, 4, pw0.z, pw0.w); ATT_SB; \
            N0 = MFMA32(kf[2], qf[1], N0); ATT_VRD(2); ATT_PK4(C0, 8, pw1.x, pw1.y); ATT_SB; \
            N1 = MFMA32(kf[3], qf[1], N1); ATT_VRD(3); ATT_PK4(C0, 12, pw1.z, pw1.w); ATT_SB; \
            N0 = MFMA32(kf[4], qf[2], N0); ATT_VRD(4); ATT_PK4(C1, 0, pw2.x, pw2.y); ATT_SB; \
            N1 = MFMA32(kf[5], qf[2], N1); ATT_VRD(5); ATT_PK4(C1, 4, pw2.z, pw2.w); ATT_SB; \
            N0 = MFMA32(kf[6], qf[3], N0); ATT_VRD(6); ATT_PK4(C1, 8, pw3.x, pw3.y); ATT_SB; \
            N1 = MFMA32(kf[7], qf[3], N1); ATT_VRD(7); ATT_PK4(C1, 12, pw3.z, pw3.w); ATT_SB; \
            l_s += is_s_ ? rs : 0.f; l_w += is_s_ ? 0.f : rs; \
            __syncthreads(); } while (0)
        int j = 0;
#pragma unroll 1
        for (; j + 1 <= n_s; j += 2) { ATT_IT(j, c0, c1, d0, d1); ATT_IT(j + 1, d0, d1, c0, c1); }
        if (j <= n_s) { ATT_IT(j, c0, c1, d0, d1); ++j; }
        { const float f_ = gt[1] / xsum32(l_s);
#pragma unroll
          for (int q = 0; q < 8; ++q) { f32x4 v_ = *(LAS f32x4*)(OT + q * 1024);
#pragma unroll
              for (int e = 0; e < 4; ++e) { v_[e] += f_ * o[q >> 2][4 * (q & 3) + e]; o[q >> 2][4 * (q & 3) + e] = 0.f; } *(LAS f32x4*)(OT + q * 1024) = v_; } }
        if ((j & 1) && j < nsteps) { ATT_IT(j, d0, d1, c0, c1); ++j; }
#pragma unroll 1
        for (; j < nsteps; j += 2) { ATT_IT(j, c0, c1, d0, d1); if (j + 1 < nsteps) ATT_IT(j + 1, d0, d1, c0, c1); }
        {
            const h8 p0_ = __builtin_bit_cast(h8, pw0), p1_ = __builtin_bit_cast(h8, pw1), p2_ = __builtin_bit_cast(h8, pw2), p3_ = __builtin_bit_cast(h8, pw3);
            o[0] = MFMA32(ATT_VF(0), p0_, o[0]); o[1] = MFMA32(ATT_VF(1), p0_, o[1]); o[0] = MFMA32(ATT_VF(2), p1_, o[0]); o[1] = MFMA32(ATT_VF(3), p1_, o[1]);
            o[0] = MFMA32(ATT_VF(4), p2_, o[0]); o[1] = MFMA32(ATT_VF(5), p2_, o[1]); o[0] = MFMA32(ATT_VF(6), p3_, o[0]); o[1] = MFMA32(ATT_VF(7), p3_, o[1]);
        }
#undef ATT_IT
#undef ATT_EX4
#undef ATT_PK4
#undef ATT_VRD
#undef ATT_VF
#undef ATT_KRD
#undef ATT_ISSUE_K2
#undef ATT_ISSUE_V2
#undef ATT_TILE_OFF
        const float f = gt[2] / xsum32(l_w);
#pragma unroll
        for (int q = 0; q < 8; ++q) { const f32x4 v = *(LAS f32x4*)(OT + q * 1024);
#pragma unroll
            for (int e = 0; e < 4; ++e) ot[q >> 2][4 * (q & 3) + e] = v[e] + f * o[q >> 2][4 * (q & 3) + e]; }
    }
    {
        float ss = 0.f;
#pragma unroll
        for (int r = 0; r < 16; ++r) ss += ot[0][r] * ot[0][r] + ot[1][r] * ot[1][r];
        ss = xsum32(ss);
        if (hi == 0) SSQ8[h * 32 + r32] = ss;
        __syncthreads();
        float tot = 0.f;
#pragma unroll
        for (int hh = 0; hh < 8; ++hh) tot += SSQ8[hh * 32 + r32];
        const float rn = 1.0f / sqrtf(tot * (1.0f / NSA_W) + EPS);
        const float* og = a.in[17] + h * HD; half_t* dst = (half_t*)(F.ws + WS_MIX) + row * D_MODEL + h * HD;
#pragma unroll
        for (int dh = 0; dh < 2; ++dh)
#pragma unroll
            for (int q4 = 0; q4 < 4; ++q4) { const int d = 32 * dh + 8 * q4 + 4 * hi; const f32x4 gv = *(const f32x4*)(og + d);
                u32x2 w; w.x = PKM(ot[dh][4 * q4] * rn * gv[0], ot[dh][4 * q4 + 1] * rn * gv[1]); w.y = PKM(ot[dh][4 * q4 + 2] * rn * gv[2], ot[dh][4 * q4 + 3] * rn * gv[3]);
                *(u32x2*)(dst + d) = w; }
        __syncthreads();
    }
}

__device__ __forceinline__ void grp_publish(unsigned* cnt) {
    asm volatile("s_waitcnt vmcnt(0)" ::: "memory"); __syncthreads();
    if (threadIdx.x == 0) __hip_atomic_fetch_add(cnt, 1u, __ATOMIC_RELAXED, __HIP_MEMORY_SCOPE_AGENT);
}
__device__ __forceinline__ void grp_wait(unsigned* cnt, unsigned want) {
    if (threadIdx.x == 0) { unsigned sp = 0;
        while (__hip_atomic_load(cnt, __ATOMIC_RELAXED, __HIP_MEMORY_SCOPE_AGENT) < want) { __builtin_amdgcn_s_sleep(2); if (++sp > (1u << 21)) break; }
        __builtin_amdgcn_fence(__ATOMIC_ACQUIRE, "agent"); asm volatile("s_waitcnt vmcnt(0)" ::: "memory"); }
    __syncthreads();
}
__global__ void __launch_bounds__(NWAVES * 64, 2) fwd_kernel(Args args) {
    extern __shared__ __attribute__((aligned(16))) unsigned char lds_raw[];
    Frame F;
    F.lds = (LAS unsigned char*)lds_raw;
    F.tid = threadIdx.x; F.lane = F.tid & 63; F.wave = __builtin_amdgcn_readfirstlane(F.tid >> 6);
    F.G = gridDim.x; { const int bx = blockIdx.x; F.vcu = (F.G % 8 == 0) ? (bx % 8) * (F.G / 8) + bx / 8 : bx; }
    F.ws = args.ws;
    volatile LAS unsigned* MISC = (volatile LAS unsigned*)(F.lds + MISC_OFF);
    for (int u = F.tid; u < (LDS_BYTES - LDSCTL_OFF) / 4; u += NWAVES * 64) ((LAS unsigned*)(F.lds + LDSCTL_OFF))[u] = 0u;
    __syncthreads();
    unsigned* ctl = (unsigned*)(args.ws + WS_CTL);
    XcdBarrier bar = xcd_barrier_post(ctl + CW_BAR + args.li * XCD_BAR_WORDS, MISC + 8);
    const int lo = args.ph_lo, hi = args.ph_hi;
#ifdef ONLY_PHASE
#define IN(k) ((k) == ONLY_PHASE && lo <= (k) && (k) < hi)
#else
#define IN(k) (lo <= (k) && (k) < hi)
#endif
#define SEAM(k) do { if (IN(k) && IN((k) + 1)) xcd_barrier(bar); } while (0)
    half_t* const wsH = (half_t*)args.ws;
#define WSH(off) ((half_t*)(args.ws + (off)))

#define RUN2(k, ...) do { if (IN(k)) { __VA_ARGS__ if (DUP_PHASE == (k)) { __VA_ARGS__ } } } while (0)
    RUN2(0, { p0_prologue(F, args); if (F.G == 256) late_weights(F, args, (int)blockIdx.x * NWAVES + F.wave, F.G * NWAVES, 2048, 1 << 30); });
    SEAM(0);
    RUN2(1, {
        pg8::Gemm g{WSH(WS_XN), WSH(WS_WIN), M, IN_PAD, 1024, 1024, 1024}; pg8::StaticOrder S; S.init(M, IN_PAD, F.G, (int)blockIdx.x);
        pg8::EpiInProj E{args.ws};
        pg8::gemm_phase<pg8::EpiInProj, pg8::StaticOrder, true, IN_BF16 != 0>(F.lds, g, S, E);
        if (F.G == 256) { if ((int)blockIdx.x >= 128) late_weights(F, args, ((int)blockIdx.x - 128) * NWAVES + F.wave, 128 * NWAVES, 0, 2048); }
        else late_weights(F, args, (int)blockIdx.x * NWAVES + F.wave, F.G * NWAVES, 0, 1 << 30);
    });
    SEAM(1);
    RUN2(2, {
        if (F.G == 256) {
            const int c = (int)blockIdx.x;
            if (c < 128) {
                const int kv = c >> 6, pmu = (c >> 3) & 7, ks = c & 7; unsigned* cnt = (unsigned*)(args.ws + WS_CTL + 122880) + 64 * (c >> 3);
                pg8::Gemm gk{WSH(WS_KC) + (size_t)kv * (KV6_STRIDE / 2) + (size_t)pmu * 256 * 1024 + ks * 256, WSH(WS_W1K) + (size_t)kv * ((WS_W1V - WS_W1K) / 2) + ks * 256, 256, 256, 256, 1024, 2048};
                pg8::SingleOrder Sk{true};
                pg8::EpiF32W Ek{args.ws, (unsigned)(WS_HIDP + ((size_t)(kv * 8 + ks) * 2048 + pmu * 256) * CMP_HID * 4), CMP_HID};
                pg8::gemm_phase<pg8::EpiF32W, pg8::SingleOrder, false>(F.lds, gk, Sk, Ek);
                grp_publish(cnt);
                conv_half(F, args, c);
                kprep(F, args);
                grp_wait(cnt, 8u);
                cmp_finalize<true>(F, args, 16 * c + F.wave, NWAVES, 16 * c + 16, kv);
            } else {
                for (int i = 0; i < 3; ++i) conv_half(F, args, 128 + 3 * (c - 128) + i);
                kprep(F, args);
            }
        } else {
            for (int it = F.vcu; it < M / 64; it += F.G) conv_item(F, args, it);
            kprep(F, args);
            __syncthreads();
            const int c = (int)blockIdx.x; const int kv = (c >> 6) & 1, pmu = (c >> 3) & 7, ks = c & 7;
            pg8::Gemm gk{WSH(WS_KC) + (size_t)kv * (KV6_STRIDE / 2) + (size_t)pmu * 256 * 1024 + ks * 256, WSH(WS_W1K) + (size_t)kv * ((WS_W1V - WS_W1K) / 2) + ks * 256, 256, 256, 256, 1024, 2048};
            pg8::SingleOrder Sk{c < 128};
            pg8::EpiF32 Ek{(float*)(args.ws + WS_HIDP) + ((size_t)(kv * 8 + ks) * 2048 + pmu * 256) * CMP_HID, CMP_HID};
            pg8::gemm_phase<pg8::EpiF32, pg8::SingleOrder, false>(F.lds, gk, Sk, Ek);
        }
    });
    SEAM(2);
    if (F.G != 256) {
        RUN2(3, { cmp_finalize<false>(F, args, F.vcu * NWAVES + F.wave, F.G * NWAVES, 2 * 16 * (NCMP_PAD / 2), -1); });
        SEAM(3);
    }
    RUN2(4, {
        for (int it = F.vcu; it < 512; it += F.G) { const int v = it & 255; const int b = v >> 5; const int s = v & 31; attn_item(F, args, b, it < 256 ? s : 63 - s); }
    });
    SEAM(4);
    RUN2(5, {
        pg8::Gemm g{WSH(WS_MIX), WSH(WS_WOUT), M, 1024, 1024, 1024, 1024}; pg8::StaticOrder S; S.init(M, 1024, F.G, (int)blockIdx.x);
        pg8::EpiOutProj E{args.in[0], WSH(WS_H1H), (float*)(args.ws + WS_SSQ)};
        pg8::gemm_phase<pg8::EpiOutProj, pg8::StaticOrder, false, MIX_BF16 != 0>(F.lds, g, S, E);
    });
    SEAM(5);
    RUN2(6, {
        pg8::Gemm g{WSH(WS_H1H), WSH(WS_WGU), M, 2 * FFN, 1024, 1024, 1024}; pg8::StaticOrder S; S.init(M, 2 * FFN, F.G, (int)blockIdx.x);
        LAS float* RT = (LAS float*)(F.lds + RING_BYTES);
        { const float* SSQ = (const float*)(args.ws + WS_SSQ);
          for (int idx = F.tid; idx < 8 * 256; idx += NWAVES * 64) { const int row = (8 * ((int)blockIdx.x & 7) + (idx >> 8)) * 256 + (idx & 255); const f32x4 sq = *(const f32x4*)(SSQ + (size_t)row * 4);
              RT[idx] = __builtin_amdgcn_rsqf(((sq[0] + sq[1]) + (sq[2] + sq[3])) * (1.0f / D_MODEL) + EPS); }
          __syncthreads(); }
        if (F.G == 256) {
            S.maxr = 5;
            pg8::EpiGateUp E{RT, args.ws, false};
            pg8::gemm_phase<pg8::EpiGateUp, pg8::StaticOrder, true, FFN_BF16 != 0>(F.lds, g, S, E);
            pg8::TailHalfOrder T{S, 5}; T.S.maxr = 1 << 30;
            pg8::EpiGateUp Eh{RT, args.ws, true};
            pg8::gemm_phase<pg8::EpiGateUp, pg8::TailHalfOrder, false, FFN_BF16 != 0, true>(F.lds, g, T, Eh);
        } else {
            pg8::EpiGateUp E{RT, args.ws, false};
            pg8::gemm_phase<pg8::EpiGateUp, pg8::StaticOrder, true, FFN_BF16 != 0>(F.lds, g, S, E);
        }
    });
    SEAM(6);
    RUN2(7, {
        pg8::Gemm g{WSH(WS_HB), WSH(WS_WDN), M, 1024, FFN, FFN, FFN}; pg8::StaticOrder S; S.init(M, 1024, F.G, (int)blockIdx.x);
        pg8::EpiDown E{WSH(WS_H1H), args.out};
        pg8::gemm_phase<pg8::EpiDown, pg8::StaticOrder, false, FFN_BF16 != 0>(F.lds, g, S, E);
    });
#undef RUN2
    (void)wsH;
#undef IN
#undef SEAM
#undef WSH
}

extern "C" void kernel_launch(void* const* d_in, const int* in_sizes, int n_in, void* d_out, int out_size, void* d_ws, size_t ws_size, hipStream_t stream) {
    static int grid = 0;
    if (grid == 0) {
        if (n_in != 23 || in_sizes[0] != M * D_MODEL || out_size != M * D_MODEL || ws_size < WS_END) { fprintf(stderr, "kernel_launch: unexpected shapes (n_in %d, in0 %d, out %d, ws %zu)\n", n_in, n_in > 0 ? in_sizes[0] : -1, out_size, ws_size); grid = -1; return; }
        int dev = 0, cus = 0;
        if (hipGetDevice(&dev) != hipSuccess || hipDeviceGetAttribute(&cus, hipDeviceAttributeMultiprocessorCount, dev) != hipSuccess) { grid = -1; return; }
        if (hipFuncSetAttribute((const void*)fwd_kernel, hipFuncAttributeMaxDynamicSharedMemorySize, LDS_BYTES) != hipSuccess) { fprintf(stderr, "kernel_launch: hipFuncSetAttribute failed\n"); grid = -1; return; }
        int per_cu = 0;
        if (hipOccupancyMaxActiveBlocksPerMultiprocessor(&per_cu, (const void*)fwd_kernel, NWAVES * 64, LDS_BYTES) != hipSuccess || per_cu < 1) fprintf(stderr, "kernel_launch: occupancy query says %d\n", per_cu);
        (void)hipGetLastError();
        grid = cus;
        if (grid != 256) fprintf(stderr, "kernel_launch: %d CUs (built for 256)\n", grid);
    }
    if (grid < 0) return;
    (void)hipMemsetAsync((char*)d_ws + WS_CTL, 0, CTL_ZERO_BYTES, stream);
    Args a{};
    for (int i = 0; i < 23; ++i) a.in[i] = (const float*)d_in[i];
    a.out = (float*)d_out; a.ws = (unsigned char*)d_ws;
#if MK_N_LAUNCHES == 1
    a.ph_lo = 0; a.ph_hi = N_PHASES; a.li = 0;
    hipLaunchKernelGGL(fwd_kernel, dim3(grid), dim3(NWAVES * 64), LDS_BYTES, stream, a);
#else
    for (int p = 0; p < N_PHASES; ++p) { a.ph_lo = p; a.ph_hi = p + 1; a.li = p; hipLaunchKernelGGL(fwd_kernel, dim3(grid), dim3(NWAVES * 64), LDS_BYTES, stream, a); }
#endif
}
```

```cpp
#include <hip/hip_runtime.h>
#include <cstdio>
#include <cstdint>

#ifndef MK_N_LAUNCHES
#define MK_N_LAUNCHES 1
#endif
#ifndef ATT_FORCE_SLOW
#define ATT_FORCE_SLOW 0
#endif
#ifndef DUP_PHASE
#define DUP_PHASE -1
#endif

typedef _Float16 half_t;
typedef _Float16 h8 __attribute__((ext_vector_type(8)));
typedef _Float16 h4 __attribute__((ext_vector_type(4)));
typedef _Float16 h2 __attribute__((ext_vector_type(2)));
typedef float f32x2 __attribute__((ext_vector_type(2)));
typedef float f32x4 __attribute__((ext_vector_type(4)));
typedef float f32x16 __attribute__((ext_vector_type(16)));
typedef unsigned u32x2 __attribute__((ext_vector_type(2)));
typedef unsigned u32x4 __attribute__((ext_vector_type(4)));
typedef short s16x4 __attribute__((ext_vector_type(4)));

#define LAS __attribute__((address_space(3)))
#define GAS __attribute__((address_space(1)))

constexpr int D_MODEL = 1024, BATCH = 8, SEQ = 2048, M = BATCH * SEQ;
constexpr int HD = 64, NH = 8, NG = 2, NSA_W = 512, CONV_CH = 512;
constexpr int NCMP = 127, NCMP_PAD = 128, CMP_HID = 256;
constexpr int FFN = 2816, IN_W = 2328, IN_PAD = 2560;
constexpr float EPS = 1e-6f;
constexpr float LOG2E = 1.4426950408889634f;

__device__ __forceinline__ unsigned pkh(float lo, float hi) { f32x2 v = {lo, hi}; h2 h = __builtin_convertvector(v, h2); return __builtin_bit_cast(unsigned, h); }
typedef __bf16 b2 __attribute__((ext_vector_type(2)));
typedef __bf16 b8 __attribute__((ext_vector_type(8)));
__device__ __forceinline__ unsigned pkb(float lo, float hi) { f32x2 v = {lo, hi}; b2 h = __builtin_convertvector(v, b2); return __builtin_bit_cast(unsigned, h); }
#ifndef FFN_BF16
#define FFN_BF16 1
#endif
#ifndef IN_BF16
#define IN_BF16 1
#endif
#ifndef MIX_BF16
#define MIX_BF16 1
#endif
#define PKM(lo, hi) (MIX_BF16 ? pkb(lo, hi) : pkh(lo, hi))
#define PKI(lo, hi) (IN_BF16 ? pkb(lo, hi) : pkh(lo, hi))
__device__ __forceinline__ float sigmoidf_(float x) { return __builtin_amdgcn_rcpf(1.0f + __builtin_amdgcn_exp2f(-x * LOG2E)); }
__device__ __forceinline__ float wave_sum(float v) {
    v += __int_as_float(__builtin_amdgcn_update_dpp(0, __float_as_int(v), 0xB1, 0xF, 0xF, true));
    v += __int_as_float(__builtin_amdgcn_update_dpp(0, __float_as_int(v), 0x4E, 0xF, 0xF, true));
    v += __int_as_float(__builtin_amdgcn_update_dpp(0, __float_as_int(v), 0x141, 0xF, 0xF, true));
    v += __int_as_float(__builtin_amdgcn_update_dpp(0, __float_as_int(v), 0x140, 0xF, 0xF, true));
    const int b = __float_as_int(v);
    return (__int_as_float(__builtin_amdgcn_readlane(b, 0)) + __int_as_float(__builtin_amdgcn_readlane(b, 16))) + (__int_as_float(__builtin_amdgcn_readlane(b, 32)) + __int_as_float(__builtin_amdgcn_readlane(b, 48)));
}

namespace pg8 {
constexpr int BM = 256, BK = 64, HALF = 128, HTB = HALF * BK * 2, STAGE_BYTES = 8 * HTB, NXCD = 8, WGM = 8;
__host__ __device__ __forceinline__ int lds_byte(int r, int c) { const int st = (r >> 4) * 2 + (c >> 5), rr = r & 15, cc = c & 31, ob = rr * 64 + cc * 2; return st * 1024 + (ob ^ (((ob >> 9) & 1) << 5)); }
__host__ __device__ __forceinline__ void stage_rc(int b, int& R, int& C) { const int st = b / 1024, sb = b % 1024, swz = sb ^ (((sb >> 9) & 1) << 5); R = (st >> 1) * 16 + swz / 64; C = (st & 1) * 32 + (swz % 64) / 2; }
__host__ __device__ __forceinline__ int perm32(int rho) { const int n = rho >> 4, i = rho & 15; return 8 * (i >> 2) + 4 * n + (i & 3); }

struct Unit { int pm, pn, hh; };
struct Gemm { const half_t* A; const half_t* Bt; int M, N, K, lda, ldb; };

struct StaticOrder {
    int nM, nN, nwg, G, c, maxr;
    __host__ __device__ void init(int M_, int N_, int G_, int c_) { nM = M_ / BM; nN = N_ / BM; nwg = nM * nN; G = G_; c = c_; maxr = 1 << 30; }
    __host__ __device__ bool next(int i, Unit& u) const {
        const long L = (long)i * G + c; if (L >= nwg || i >= maxr) return false; u.hh = 0;
        int wgid = (int)L; { const int q = nwg / NXCD, r = nwg % NXCD, xcd = wgid % NXCD, off = wgid / NXCD; wgid = (xcd < r ? xcd * (q + 1) : r * (q + 1) + (xcd - r) * q) + off; }
        const int nig = WGM * nN, gid = wgid / nig, fm = gid * WGM, gsz = (nM - fm) < WGM ? (nM - fm) : WGM;
        u.pm = fm + ((wgid % nig) % gsz); u.pn = (wgid % nig) / gsz; return true;
    }
};

struct SingleOrder { bool has; __device__ bool next(int i, Unit& u) const { if (i == 0 && has) { u.pm = 0; u.pn = 0; u.hh = 0; return true; } return false; } };
struct TailHalfOrder { StaticOrder S; int r;
    __device__ bool next(int i, Unit& u) const { if (i != 0) return false; StaticOrder T = S; const int half = S.G / 2; T.c = S.c % half; if (!T.next(r, u)) return false; u.hh = S.c / half; return true; } };
struct NoPre { __device__ __forceinline__ void arrive() {} __device__ __forceinline__ void wait() {} };
template <class Epi, class Sched, bool ALIGN_EPI, bool BF = false, bool HALFM = false, bool PRE = false, class Pre = NoPre>
__device__ __forceinline__ void gemm_phase_i(LAS unsigned char* lds, const Gemm g, const Sched& S, const Epi& E, Pre pre) {
    int tid = threadIdx.x; asm volatile("" : "+v"(tid));
    const int wid = __builtin_amdgcn_readfirstlane(tid >> 6), lane = tid & 63, wr = wid >> 2, wc = wid & 3, fr = lane & 15, fq = lane >> 4;
    const int K = g.K, nt = K / BK;
    unsigned voffA[2], voffB[2];
#pragma unroll
    for (int i = 0; i < 2; ++i) { int R, C; stage_rc(tid * 16 + i * 8192, R, C); const int Rb = Epi::PERM ? ((R & ~31) + perm32(R & 31)) : R;
        voffA[i] = (unsigned)(R * g.lda + C) * 2u; voffB[i] = (unsigned)(Rb * g.ldb + C) * 2u; }
    const size_t kstep = (size_t)(BK * 2);
    const size_t hstepA = (size_t)HALF * g.lda * 2, hstepB = (size_t)HALF * g.ldb * 2;
    const size_t tstepA = 2 * hstepA, tstepB = 2 * hstepB;
    const unsigned ldsw = (unsigned)wid * 1024u;
    const int aoff = lds_byte(wr * 64 + fr, fq * 8), boff = lds_byte(wc * 32 + fr, fq * 8);
#define PG8_SA(b, h) (((b) * 2 + (h)) * HTB)
#define PG8_SB(b, h) ((4 + (b) * 2 + (h)) * HTB)
#define PG8_STAGE(bufoff, gbase, voff) do { _Pragma("unroll") for (int _i = 0; _i < 2; ++_i) \
        __builtin_amdgcn_global_load_lds((const unsigned*)((const char*)(gbase) + (voff)[_i]), (LAS unsigned*)(lds + (bufoff) + ldsw + _i * 8192), 16, 0, 0); } while (0)
#define PG8_LDA(dst, b, h) do { _Pragma("unroll") for (int m = 0; m < 4; ++m) _Pragma("unroll") for (int k = 0; k < 2; ++k) dst[m][k] = *(const LAS h8*)(lds + PG8_SA(b, h) + aoff + m * 2048 + k * 1024); } while (0)
#define PG8_LDB(dst, b, h) do { _Pragma("unroll") for (int n = 0; n < 2; ++n) _Pragma("unroll") for (int k = 0; k < 2; ++k) dst[n][k] = *(const LAS h8*)(lds + PG8_SB(b, h) + boff + n * 2048 + k * 1024); } while (0)
#define PG8_MMA(ai, bj, At, Bt) do { __builtin_amdgcn_s_setprio(1); _Pragma("unroll") for (int m = 0; m < 4; ++m) _Pragma("unroll") for (int n = 0; n < 2; ++n) _Pragma("unroll") for (int k = 0; k < 2; ++k) \
        acc[ai][bj][m][n] = BF ? __builtin_amdgcn_mfma_f32_16x16x32_bf16(__builtin_bit_cast(b8, Bt[n][k]), __builtin_bit_cast(b8, At[m][k]), acc[ai][bj][m][n], 0, 0, 0) \
                               : __builtin_amdgcn_mfma_f32_16x16x32_f16(Bt[n][k], At[m][k], acc[ai][bj][m][n], 0, 0, 0); __builtin_amdgcn_s_setprio(0); } while (0)
#define PG8_MMAZ(Z, ai, bj, At, Bt) do { __builtin_amdgcn_s_setprio(1); _Pragma("unroll") for (int m = 0; m < 4; ++m) _Pragma("unroll") for (int n = 0; n < 2; ++n) _Pragma("unroll") for (int k = 0; k < 2; ++k) { \
        const f32x4 c_ = ((Z) && k == 0) ? (f32x4){0.f, 0.f, 0.f, 0.f} : acc[ai][bj][m][n]; \
        acc[ai][bj][m][n] = BF ? __builtin_amdgcn_mfma_f32_16x16x32_bf16(__builtin_bit_cast(b8, Bt[n][k]), __builtin_bit_cast(b8, At[m][k]), c_, 0, 0, 0) \
                               : __builtin_amdgcn_mfma_f32_16x16x32_f16(Bt[n][k], At[m][k], c_, 0, 0, 0); } __builtin_amdgcn_s_setprio(0); } while (0)
#define PG8_WAIT_V(n) asm volatile("s_waitcnt vmcnt(" #n ")" ::: "memory")
#define PG8_WAIT_L(n) asm volatile("s_waitcnt lgkmcnt(" #n ")" ::: "memory")
#define PG8_BAR __builtin_amdgcn_s_barrier()
#define PG8_SCHED __builtin_amdgcn_sched_barrier(0)
    Unit cur, nxt; int ui = 0;
    const bool has0 = S.next(0, cur);
    if (!PRE && !has0) return;
    f32x4 acc[2][2][4][2];
    if constexpr (PRE) {
        pre.arrive();
        if (wid != 0) E.preload(acc, cur, wr, wc, fr, fq);
        pre.wait();
        if (wid == 0) E.preload(acc, cur, wr, wc, fr, fq);
        if (!has0) return;
    } else if constexpr (!(Epi::ZPEEL && ALIGN_EPI && !HALFM)) {
#pragma unroll
    for (int a = 0; a < 2; ++a)
#pragma unroll
        for (int b = 0; b < 2; ++b)
#pragma unroll
            for (int m = 0; m < 4; ++m)
#pragma unroll
                for (int n = 0; n < 2; ++n) acc[a][b][m][n] = (f32x4){0.f, 0.f, 0.f, 0.f};
    }
    h8 At[4][2], B0[2][2], B1[2][2];
    const char* cA = (const char*)g.A + (size_t)cur.pm * tstepA + (HALFM ? (size_t)cur.hh * hstepA : 0); const char* cB = (const char*)g.Bt + (size_t)cur.pn * tstepB;
#define PG8_STAGE_A1(bufoff, gbase, voff) do { if (!HALFM) PG8_STAGE(bufoff, gbase, voff); } while (0)
#define PG8_WAIT_VH(n_full, n_half) do { if (HALFM) PG8_WAIT_V(n_half); else PG8_WAIT_V(n_full); } while (0)
    PG8_STAGE(PG8_SB(0, 0), cB, voffB); PG8_STAGE(PG8_SB(0, 1), cB + hstepB, voffB); PG8_STAGE(PG8_SA(0, 0), cA, voffA); PG8_STAGE_A1(PG8_SA(0, 1), cA + hstepA, voffA);
    if (wr == 1) PG8_BAR;
    PG8_WAIT_VH(2, 0); PG8_BAR;
    PG8_STAGE(PG8_SB(1, 0), cB + kstep, voffB); PG8_STAGE(PG8_SA(1, 0), cA + kstep, voffA); PG8_STAGE(PG8_SB(1, 1), cB + hstepB + kstep, voffB);
    PG8_WAIT_V(6); PG8_BAR;
    for (;;) {
        const bool has_next = S.next(ui + 1, nxt);
        const char* nA = has_next ? (const char*)g.A + (size_t)nxt.pm * tstepA + (HALFM ? (size_t)nxt.hh * hstepA : 0) : cA; const char* nB = has_next ? (const char*)g.Bt + (size_t)nxt.pn * tstepB : cB;
#define PG8_KSTEP(Z_) do { \
            const bool last = (t == nt - 2); \
            const char* a1 = cA + (size_t)(t + 1) * kstep; \
            const char* a2 = last ? nA : cA + (size_t)(t + 2) * kstep; const char* b2 = last ? nB : cB + (size_t)(t + 2) * kstep; \
            const char* a3 = a2 + kstep; const char* b3 = b2 + kstep; \
            PG8_LDB(B0, 0, 0); PG8_LDB(B1, 0, 1); PG8_SCHED; PG8_LDA(At, 0, 0); PG8_STAGE_A1(PG8_SA(1, 1), a1 + hstepA, voffA); \
            PG8_WAIT_VH(8, 6); PG8_WAIT_L(0); PG8_BAR; PG8_MMAZ(Z_, 0, 0, At, B0); PG8_MMAZ(Z_, 0, 1, At, B1); PG8_BAR; PG8_SCHED; \
            if (!HALFM) PG8_LDA(At, 0, 1); PG8_STAGE(PG8_SB(0, 0), b2, voffB); PG8_STAGE(PG8_SB(0, 1), b2 + hstepB, voffB); PG8_STAGE(PG8_SA(0, 0), a2, voffA); \
            PG8_WAIT_VH(8, 6); PG8_WAIT_L(0); PG8_BAR; if (!HALFM) { PG8_MMAZ(Z_, 1, 0, At, B0); PG8_MMAZ(Z_, 1, 1, At, B1); } PG8_BAR; PG8_SCHED; \
            PG8_LDB(B0, 1, 0); PG8_LDB(B1, 1, 1); PG8_SCHED; PG8_LDA(At, 1, 0); PG8_STAGE_A1(PG8_SA(0, 1), a2 + hstepA, voffA); \
            PG8_WAIT_VH(8, 6); PG8_WAIT_L(0); PG8_BAR; PG8_MMA(0, 0, At, B0); PG8_MMA(0, 1, At, B1); PG8_BAR; PG8_SCHED; \
            if (!HALFM) PG8_LDA(At, 1, 1); PG8_STAGE(PG8_SB(1, 0), b3, voffB); PG8_STAGE(PG8_SB(1, 1), b3 + hstepB, voffB); PG8_STAGE(PG8_SA(1, 0), a3, voffA); \
            PG8_WAIT_VH(8, 6); PG8_WAIT_L(0); PG8_BAR; if (!HALFM) { PG8_MMA(1, 0, At, B0); PG8_MMA(1, 1, At, B1); } PG8_BAR; PG8_SCHED; \
        } while (0)
        { int t = 0;
          if constexpr (!PRE && Epi::ZPEEL && ALIGN_EPI && !HALFM) { PG8_KSTEP(1); t = 2; }
          for (; t < nt; t += 2) { PG8_KSTEP(0); } }
#undef PG8_KSTEP
        if constexpr (ALIGN_EPI) { if (wr == 0) PG8_BAR; }
        if constexpr (!Epi::AFTER_DRAIN) { E(acc, cur, wr, wc, fr, fq); }
        if (!has_next) break;
        if constexpr (PRE || !(Epi::ZPEEL && ALIGN_EPI && !HALFM)) {
#pragma unroll
        for (int a = 0; a < 2; ++a)
#pragma unroll
            for (int b = 0; b < 2; ++b)
#pragma unroll
                for (int m = 0; m < 4; ++m)
#pragma unroll
                    for (int n = 0; n < 2; ++n) acc[a][b][m][n] = (f32x4){0.f, 0.f, 0.f, 0.f};
        }
        cur = nxt; cA = nA; cB = nB; ++ui;
        if constexpr (ALIGN_EPI) { if (wr == 1) PG8_BAR; }
    }
    PG8_WAIT_V(0);
    if constexpr (!ALIGN_EPI) { if (wr == 0) PG8_BAR; }
    PG8_BAR;
    if constexpr (Epi::AFTER_DRAIN) { E.fused(acc, cur, wr, wc, fr, fq, lds, wid, lane); }
#undef PG8_SA
#undef PG8_SB
#undef PG8_STAGE
#undef PG8_STAGE_A1
#undef PG8_WAIT_VH
#undef PG8_LDA
#undef PG8_LDB
#undef PG8_MMA
#undef PG8_WAIT_V
#undef PG8_WAIT_L
#undef PG8_BAR
#undef PG8_SCHED
}
template <class Epi, class Sched, bool ALIGN_EPI, bool BF = false, bool HALFM = false>
__device__ __forceinline__ void gemm_phase(LAS unsigned char* lds, const Gemm g, const Sched& S, const Epi& E) { gemm_phase_i<Epi, Sched, ALIGN_EPI, BF, HALFM, false, NoPre>(lds, g, S, E, NoPre()); }

struct EpiInProj {
    static constexpr bool ZPEEL = true; static constexpr bool PERM = true, AFTER_DRAIN = false;
    unsigned char* ws;
    __device__ __forceinline__ void operator()(const f32x4 (&acc)[2][2][4][2], const Unit& u, int wr, int wc, int fr, int fq) const {
        { int l_; asm volatile("v_mbcnt_lo_u32_b32 %0, -1, 0\n\tv_mbcnt_hi_u32_b32 %0, -1, %0" : "=v"(l_)); fr = l_ & 15; fq = l_ >> 4; }
        const int pn = u.pn, c8 = wc * 32 + 8 * fq;
#pragma unroll
        for (int ai = 0; ai < 2; ++ai)
#pragma unroll
            for (int m = 0; m < 4; ++m) {
                const int row = u.pm * BM + ai * HALF + wr * 64 + m * 16 + fr;
                if (pn < 5) {
                    size_t off0, bjstep;
                    if (pn < 2) { off0 = 134217728ull   + ((size_t)row * NSA_W + pn * 256 + c8) * 2; bjstep = HALF * 2; }
                    else { const int b = row >> 11, t = row & 2047, gg = c8 >> 6, d = c8 & 63;
                        off0 = 167772160ull   + (size_t)((pn - 2) * 2) * 5242880ull + (((size_t)((b * 2 + gg) * SEQ + t)) * HD + d) * 2; bjstep = 5242880ull; }
#pragma unroll
                    for (int bj = 0; bj < 2; ++bj) { const f32x4 v0 = acc[ai][bj][m][0], v1 = acc[ai][bj][m][1];
                        u32x4 w; w.x = pkh(v0[0], v0[1]); w.y = pkh(v0[2], v0[3]); w.z = pkh(v1[0], v1[1]); w.w = pkh(v1[2], v1[3]);
                        *(u32x4*)(ws + off0 + bj * bjstep) = w; }
                } else if (pn < 9) {
                    float o[8];
#pragma unroll
                    for (int n = 0; n < 2; ++n)
#pragma unroll
                        for (int j = 0; j < 4; ++j) o[n * 4 + j] = acc[ai][0][m][n][j] * sigmoidf_(acc[ai][1][m][n][j]);
                    u32x4 w; w.x = pkh(o[0], o[1]); w.y = pkh(o[2], o[3]); w.z = pkh(o[4], o[5]); w.w = pkh(o[6], o[7]);
                    *(u32x4*)(ws + 150994944ull   + ((size_t)row * CONV_CH + (pn - 5) * HALF + c8) * 2) = w;
                } else {
                    if (wc == 0 && fq < 3) {
#pragma unroll
                        for (int n = 0; n < 2; ++n) { f32x4 v = acc[ai][0][m][n]; f32x4 s; s[0] = sigmoidf_(v[0]); s[1] = sigmoidf_(v[1]); s[2] = sigmoidf_(v[2]); s[3] = sigmoidf_(v[3]);
                            *(f32x4*)(ws + 31457280ull   + ((size_t)row * 24 + 8 * fq + 4 * n) * 4) = s; }
                    }
                }
            }
    }
};
struct EpiF32 {
    static constexpr bool ZPEEL = false; static constexpr bool PERM = false, AFTER_DRAIN = false;
    float* C; int ldc;
    __device__ __forceinline__ void operator()(const f32x4 (&acc)[2][2][4][2], const Unit& u, int wr, int wc, int fr, int fq) const {
        const int row0 = u.pm * BM + wr * 64 + fr, col0 = u.pn * BM + wc * 32 + 4 * fq;
#pragma unroll
        for (int ai = 0; ai < 2; ++ai)
#pragma unroll
            for (int m = 0; m < 4; ++m) { float* rowp = C + (size_t)(row0 + ai * HALF + m * 16) * ldc + col0;
#pragma unroll
                for (int bj = 0; bj < 2; ++bj)
#pragma unroll
                    for (int n = 0; n < 2; ++n) *(f32x4*)(rowp + bj * HALF + n * 16) = acc[ai][bj][m][n]; }
    }
};
struct EpiF32W {
    static constexpr bool ZPEEL = false; static constexpr bool PERM = false, AFTER_DRAIN = false;
    unsigned char* ws; unsigned off; int ldc;
    __device__ __forceinline__ void operator()(const f32x4 (&acc)[2][2][4][2], const Unit& u, int wr, int wc, int fr, int fq) const {
        const __amdgpu_buffer_rsrc_t rs = __builtin_amdgcn_make_buffer_rsrc(ws, 0, 0x10000000, 0x00020000);
        const int row0 = u.pm * BM + wr * 64 + fr, col0 = u.pn * BM + wc * 32 + 4 * fq;
#pragma unroll
        for (int ai = 0; ai < 2; ++ai)
#pragma unroll
            for (int m = 0; m < 4; ++m) { const unsigned ro = off + (unsigned)((row0 + ai * HALF + m * 16) * ldc + col0) * 4u;
#pragma unroll
                for (int bj = 0; bj < 2; ++bj)
#pragma unroll
                    for (int n = 0; n < 2; ++n) __builtin_amdgcn_raw_buffer_store_b128(__builtin_bit_cast(u32x4, acc[ai][bj][m][n]), rs, ro + (unsigned)(bj * HALF + n * 16) * 4u, 0, 16); }
    }
};
struct EpiOutProj {
    static constexpr bool ZPEEL = false; static constexpr bool PERM = true, AFTER_DRAIN = true;
    const float* x; half_t* H1H; float* SSQ; bool pre;
    __device__ __forceinline__ void preload(f32x4 (&acc)[2][2][4][2], const Unit& u, int wr, int wc, int fr, int fq) const {
        const float* xb_ = x + (size_t)(u.pm * BM + wr * 64 + fr) * D_MODEL + u.pn * BM + wc * 32 + 8 * fq;
#pragma unroll
        for (int a = 0; a < 2; ++a)
#pragma unroll
            for (int b = 0; b < 2; ++b)
#pragma unroll
                for (int m = 0; m < 4; ++m)
#pragma unroll
                    for (int n = 0; n < 2; ++n) acc[a][b][m][n] = __builtin_nontemporal_load((const f32x4*)(xb_ + (size_t)(a * HALF + m * 16) * D_MODEL + b * HALF + n * 4));
    }
    __device__ __forceinline__ void fused(f32x4 (&acc)[2][2][4][2], const Unit& u, int wr, int wc, int fr, int fq, LAS unsigned char* lds, int wid, int lane) const {
        LAS float* P = (LAS float*)lds;
        const int col0 = u.pn * BM + wc * 32 + 8 * fq;
        f32x4 xa[8], xb[8];
#define OP_LOAD(b, D) do { _Pragma("unroll") for (int mm = 0; mm < 2; ++mm) { const int rl_ = ((b) >> 1) * HALF + wr * 64 + (((b) & 1) * 2 + mm) * 16 + fr; const size_t off_ = (size_t)(u.pm * BM + rl_) * D_MODEL + col0; \
            _Pragma("unroll") for (int q = 0; q < 4; ++q) D[mm * 4 + q] = __builtin_nontemporal_load((const f32x4*)(x + off_ + (q >> 1) * HALF + (q & 1) * 4)); } } while (0)
#define OP_PROC(b, D) do { _Pragma("unroll") for (int mm = 0; mm < 2; ++mm) { const int ai = (b) >> 1, m = ((b) & 1) * 2 + mm; const int rl = ai * HALF + wr * 64 + m * 16 + fr; const size_t off = (size_t)(u.pm * BM + rl) * D_MODEL + col0; float ss = 0.f; \
            _Pragma("unroll") for (int bj = 0; bj < 2; ++bj) { const f32x4 h = D[mm * 4 + bj * 2] + acc[ai][bj][m][0], k = D[mm * 4 + bj * 2 + 1] + acc[ai][bj][m][1]; \
                u32x4 w; if (FFN_BF16) { w.x = pkb(h[0], h[1]); w.y = pkb(h[2], h[3]); w.z = pkb(k[0], k[1]); w.w = pkb(k[2], k[3]); } else { w.x = pkh(h[0], h[1]); w.y = pkh(h[2], h[3]); w.z = pkh(k[0], k[1]); w.w = pkh(k[2], k[3]); } \
                *(u32x4*)(H1H + off + bj * HALF) = w; \
                ss += ((h[0] * h[0] + h[1] * h[1]) + (h[2] * h[2] + h[3] * h[3])) + ((k[0] * k[0] + k[1] * k[1]) + (k[2] * k[2] + k[3] * k[3])); } \
            ss += __shfl_xor(ss, 16); ss += __shfl_xor(ss, 32); \
            if (fq == 0) P[rl * 4 + wc] = ss; } } while (0)
        f32x4 xc[8];
        if (pre) {
#pragma unroll
            for (int q = 0; q < 8; ++q) xa[q] = (f32x4){0.f, 0.f, 0.f, 0.f};
            OP_PROC(0, xa); OP_PROC(1, xa); OP_PROC(2, xa); OP_PROC(3, xa);
        } else {
        OP_LOAD(0, xa); OP_LOAD(1, xb); OP_LOAD(2, xc);
        OP_PROC(0, xa); OP_LOAD(3, xa);
        OP_PROC(1, xb); OP_PROC(2, xc); OP_PROC(3, xa);
        }
#undef OP_LOAD
#undef OP_PROC
        asm volatile("s_waitcnt lgkmcnt(0)" ::: "memory"); __builtin_amdgcn_s_barrier(); asm volatile("" ::: "memory");
        const int tid = wid * 64 + lane;
        if (tid < 256) { const float s = (P[tid * 4 + 0] + P[tid * 4 + 1]) + (P[tid * 4 + 2] + P[tid * 4 + 3]); SSQ[(size_t)(u.pm * BM + tid) * 4 + u.pn] = s; }
        asm volatile("s_waitcnt lgkmcnt(0)" ::: "memory"); __builtin_amdgcn_s_barrier(); asm volatile("" ::: "memory");
    }
};
struct EpiGateUp {
    static constexpr bool ZPEEL = true; static constexpr bool PERM = true, AFTER_DRAIN = false;
    const LAS float* RT; unsigned char* ws; bool half;
    __device__ __forceinline__ void operator()(const f32x4 (&acc)[2][2][4][2], const Unit& u, int wr, int wc, int fr, int fq) const {
        { int l_; asm volatile("v_mbcnt_lo_u32_b32 %0, -1, 0\n\tv_mbcnt_hi_u32_b32 %0, -1, %0" : "=v"(l_)); fr = l_ & 15; fq = l_ >> 4; }
        const int c8 = wc * 32 + 8 * fq;
        const __amdgpu_buffer_rsrc_t rs = __builtin_amdgcn_make_buffer_rsrc(ws, 0, 0x10000000, 0x00020000);
#pragma unroll
        for (int ai = 0; ai < 2; ++ai)
#pragma unroll
            for (int m = 0; m < 4; ++m) {
                if (half && ai == 1) continue;
                const int rl = (half ? u.hh : ai) * HALF + wr * 64 + m * 16 + fr, row = u.pm * BM + rl;
                const float r = RT[(u.pm & 7) * BM + rl];
                typedef float f32p __attribute__((ext_vector_type(2)));
                const f32p rl2 = {-r * LOG2E, -r * LOG2E}, rr2 = {r * r, r * r}, one2 = {1.0f, 1.0f};
                float o[8];
#pragma unroll
                for (int n = 0; n < 2; ++n)
#pragma unroll
                    for (int j = 0; j < 4; j += 2) { const f32p a2 = {acc[ai][0][m][n][j], acc[ai][0][m][n][j + 1]}, b2 = {acc[ai][1][m][n][j], acc[ai][1][m][n][j + 1]};
                        const f32p z = a2 * rl2, t = (a2 * b2) * rr2; f32p e; e[0] = __builtin_amdgcn_exp2f(z[0]); e[1] = __builtin_amdgcn_exp2f(z[1]);
                        const f32p d = e + one2; f32p q; q[0] = __builtin_amdgcn_rcpf(d[0]); q[1] = __builtin_amdgcn_rcpf(d[1]);
                        const f32p h = t * q; o[n * 4 + j] = h[0]; o[n * 4 + j + 1] = h[1]; }
                u32x4 w; if (FFN_BF16) { w.x = pkb(o[0], o[1]); w.y = pkb(o[2], o[3]); w.z = pkb(o[4], o[5]); w.w = pkb(o[6], o[7]); } else { w.x = pkh(o[0], o[1]); w.y = pkh(o[2], o[3]); w.z = pkh(o[4], o[5]); w.w = pkh(o[6], o[7]); }
                __builtin_amdgcn_raw_buffer_store_b128(w, rs, (unsigned)(100663296u + ((unsigned)row * FFN + u.pn * HALF + c8) * 2u), 0, 0);
            }
    }
};
struct EpiDown {
    static constexpr bool ZPEEL = false; static constexpr bool PERM = true, AFTER_DRAIN = false;
    const half_t* H1H; float* out; bool pre;
    __device__ __forceinline__ void preload(f32x4 (&acc)[2][2][4][2], const Unit& u, int wr, int wc, int fr, int fq) const {
        const int row0 = u.pm * BM + wr * 64 + fr, col0 = u.pn * BM + wc * 32 + 8 * fq;
        u32x4 hh[2][4][2];
#pragma unroll
        for (int ai = 0; ai < 2; ++ai)
#pragma unroll
            for (int m = 0; m < 4; ++m) { const size_t off = (size_t)(row0 + ai * HALF + m * 16) * D_MODEL + col0;
#pragma unroll
                for (int bj = 0; bj < 2; ++bj) hh[ai][m][bj] = __builtin_nontemporal_load((const u32x4*)(H1H + off + bj * HALF)); }
#pragma unroll
        for (int ai = 0; ai < 2; ++ai)
#pragma unroll
            for (int m = 0; m < 4; ++m)
#pragma unroll
                for (int bj = 0; bj < 2; ++bj) { const u32x4 hv = hh[ai][m][bj]; f32x4 h, k;
                    if (FFN_BF16) { h[0] = __uint_as_float(hv.x << 16); h[1] = __uint_as_float(hv.x & 0xffff0000u); h[2] = __uint_as_float(hv.y << 16); h[3] = __uint_as_float(hv.y & 0xffff0000u);
                                    k[0] = __uint_as_float(hv.z << 16); k[1] = __uint_as_float(hv.z & 0xffff0000u); k[2] = __uint_as_float(hv.w << 16); k[3] = __uint_as_float(hv.w & 0xffff0000u); }
                    else { const h8 q = __builtin_bit_cast(h8, hv); h[0] = (float)q[0]; h[1] = (float)q[1]; h[2] = (float)q[2]; h[3] = (float)q[3]; k[0] = (float)q[4]; k[1] = (float)q[5]; k[2] = (float)q[6]; k[3] = (float)q[7]; }
                    acc[ai][bj][m][0] = h; acc[ai][bj][m][1] = k; }
    }
    __device__ __forceinline__ void operator()(const f32x4 (&acc)[2][2][4][2], const Unit& u, int wr, int wc, int fr, int fq) const {
        const int row0 = u.pm * BM + wr * 64 + fr, col0 = u.pn * BM + wc * 32 + 8 * fq;
        if (pre) {
#pragma unroll
            for (int ai = 0; ai < 2; ++ai)
#pragma unroll
                for (int m = 0; m < 4; ++m) { const size_t off = (size_t)(row0 + ai * HALF + m * 16) * D_MODEL + col0;
#pragma unroll
                    for (int bj = 0; bj < 2; ++bj) { *(f32x4*)(out + off + bj * HALF) = acc[ai][bj][m][0]; *(f32x4*)(out + off + bj * HALF + 4) = acc[ai][bj][m][1]; } }
            return;
        }
        u32x4 hh[2][4][2];
#pragma unroll
        for (int ai = 0; ai < 2; ++ai)
#pragma unroll
            for (int m = 0; m < 4; ++m) { const size_t off = (size_t)(row0 + ai * HALF + m * 16) * D_MODEL + col0;
#pragma unroll
                for (int bj = 0; bj < 2; ++bj) hh[ai][m][bj] = __builtin_nontemporal_load((const u32x4*)(H1H + off + bj * HALF)); }
#pragma unroll
        for (int ai = 0; ai < 2; ++ai)
#pragma unroll
            for (int m = 0; m < 4; ++m) { const size_t off = (size_t)(row0 + ai * HALF + m * 16) * D_MODEL + col0;
#pragma unroll
                for (int bj = 0; bj < 2; ++bj) { const u32x4 hv = hh[ai][m][bj]; f32x4 h, k;
                    if (FFN_BF16) { h[0] = __uint_as_float(hv.x << 16); h[1] = __uint_as_float(hv.x & 0xffff0000u); h[2] = __uint_as_float(hv.y << 16); h[3] = __uint_as_float(hv.y & 0xffff0000u);
                                    k[0] = __uint_as_float(hv.z << 16); k[1] = __uint_as_float(hv.z & 0xffff0000u); k[2] = __uint_as_float(hv.w << 16); k[3] = __uint_as_float(hv.w & 0xffff0000u); }
                    else { const h8 q = __builtin_bit_cast(h8, hv); h[0] = (float)q[0]; h[1] = (float)q[1]; h[2] = (float)q[2]; h[3] = (float)q[3]; k[0] = (float)q[4]; k[1] = (float)q[5]; k[2] = (float)q[6]; k[3] = (float)q[7]; }
                    *(f32x4*)(out + off + bj * HALF) = h + acc[ai][bj][m][0]; *(f32x4*)(out + off + bj * HALF + 4) = k + acc[ai][bj][m][1]; } }
    }
};
}

constexpr int NWAVES = 8;
constexpr int N_PHASES = 8;
constexpr size_t MiB = 1u << 20;
constexpr size_t WS_CTL = 0, CTL_ZERO_BYTES = 128 * 1024;
constexpr size_t WS_BIASP = 1 * MiB;
constexpr size_t WS_ROPEC = 1 * MiB + 64 * 1024;
constexpr size_t WS_ROPES = WS_ROPEC + 256 * 1024;
constexpr size_t WS_SSQ = WS_ROPES + 256 * 1024;
constexpr size_t WS_GMAX = 1 * MiB + 32 * 1024;
constexpr size_t WS_W1K = 3 * MiB, WS_W1V = 4 * MiB;
constexpr size_t WS_WIN = 5 * MiB;
constexpr size_t WS_WOUT = 10 * MiB;
constexpr size_t WS_WGU = 12 * MiB;
constexpr size_t WS_WDN = 23 * MiB;
constexpr size_t WS_KCMP = 29 * MiB, WS_VCMP = 29 * MiB + 256 * 1024;
constexpr size_t WS_GATES = 30 * MiB;
constexpr size_t WS_H1H = 32 * MiB;
constexpr size_t WS_MIX = 64 * MiB;
constexpr size_t WS_HB = 96 * MiB;
constexpr size_t WS_XN = 96 * MiB;
constexpr size_t WS_Q = 128 * MiB;
constexpr size_t WS_HCV = 144 * MiB;
constexpr size_t WS_KV6 = 160 * MiB, KV6_STRIDE = 5 * MiB;
constexpr size_t WS_KC = WS_KV6, WS_VC = WS_KV6 + KV6_STRIDE, WS_KSR = WS_KV6 + 2 * KV6_STRIDE, WS_VS = WS_KV6 + 3 * KV6_STRIDE, WS_KWR = WS_KV6 + 4 * KV6_STRIDE, WS_VW = WS_KV6 + 5 * KV6_STRIDE;
constexpr size_t WS_HIDP = 96 * MiB;
constexpr size_t WS_KS = 200 * MiB, WS_KW = 204 * MiB;
constexpr size_t WS_END = 208 * MiB;
static_assert(WS_HB == 100663296ull, "EpiGateUp literal offset");
static_assert(WS_Q == 134217728ull && WS_KV6 == 167772160ull && KV6_STRIDE == 5242880ull && WS_HCV == 150994944ull && WS_GATES == 31457280ull, "EpiInProj literal offsets");
constexpr int CW_BAR = 1024;

constexpr int RING_BYTES = 131072;
constexpr int LDSCTL_OFF = 147456, MISC_OFF = LDSCTL_OFF + 320;
constexpr int LDS_BYTES = 147456 + 1024;

typedef GAS unsigned gu32;
#define RLX_AGENT __ATOMIC_RELAXED, __HIP_MEMORY_SCOPE_AGENT

#define XB_TMO      128
#define XB_XCNT(j)  (256  + 64 * (j))
#define XB_XSUB(j)  (1280 + 64 * (j))
#define XB_XGEN(j)  (2304 + 64 * (j))
#define XB_TOP      3328
#define XB_TOPGEN   3392
#define XCD_BAR_WORDS 3456
#define XB_SPIN_CAP (1u << 22)
__device__ __forceinline__ unsigned xb_ld(unsigned* p)              { return __hip_atomic_load(p, __ATOMIC_RELAXED, __HIP_MEMORY_SCOPE_AGENT); }
__device__ __forceinline__ unsigned xb_add(unsigned* p, unsigned v) { return __hip_atomic_fetch_add(p, v, __ATOMIC_RELAXED, __HIP_MEMORY_SCOPE_AGENT); }
__device__ __forceinline__ unsigned xb_xcc_id() { return (unsigned)__builtin_amdgcn_s_getreg((3 << 11) | 20) & 0xFu; }
#define XB_SPIN(cond, bar) do { unsigned _sp = 0; while (cond) { __builtin_amdgcn_s_sleep(1); \
    if ((++_sp & 255u) == 0u) { if (xb_ld(&(bar)[XB_TMO])) break; if (_sp > XB_SPIN_CAP) { atomicAdd(&(bar)[XB_TMO], 1u); break; } } } } while (0)
struct XcdBarrier { unsigned* bar; unsigned x; volatile LAS unsigned* st; };
__device__ __forceinline__ XcdBarrier xcd_barrier_post(unsigned* bar, volatile LAS unsigned* st) {
    XcdBarrier b; b.bar = bar; b.x = xb_xcc_id(); b.st = st;
    if (threadIdx.x == 0) (void)xb_add(&bar[XB_XCNT(b.x)], 1u);
    return b;
}
__device__ __forceinline__ void xcd_barrier_complete(unsigned* bar, unsigned x, unsigned& nloc, unsigned& nx) {
    const unsigned G = gridDim.x * gridDim.y * gridDim.z;
    unsigned sum, cnt, mine, sp = 0u;
    for (;;) {
        sum = 0u; cnt = 0u; mine = 0u;
#pragma unroll
        for (unsigned j = 0; j < 16; ++j) { const unsigned c = xb_ld(&bar[XB_XCNT(j)]); sum += c; cnt += (c > 0u) ? 1u : 0u; mine = (j == x) ? c : mine; }
        if (sum == G) break;
        __builtin_amdgcn_s_sleep(1);
        if ((++sp & 255u) == 0u) { if (xb_ld(&bar[XB_TMO])) break; if (sp > XB_SPIN_CAP) { atomicAdd(&bar[XB_TMO], 1u); break; } }
    }
    nloc = mine > 0u ? mine : 1u; nx = cnt > 0u ? cnt : 1u;
}
__device__ __forceinline__ void xcd_barrier(const XcdBarrier& b) {
    asm volatile("s_waitcnt vmcnt(0)" ::: "memory");
    __syncthreads();
    if (threadIdx.x == 0) {
        unsigned* bar = b.bar;
        __builtin_amdgcn_s_waitcnt(0);
        unsigned nloc = b.st[0], nx = b.st[1];
        if (nloc == 0u) { xcd_barrier_complete(bar, b.x, nloc, nx); b.st[0] = nloc; b.st[1] = nx; }
        const unsigned old = xb_add(&bar[XB_XSUB(b.x)], 1u);
        const unsigned gen = old / nloc;
        if (old + 1u == (gen + 1u) * nloc) {
            __builtin_amdgcn_fence(__ATOMIC_RELEASE, "agent");
            asm volatile("s_waitcnt vmcnt(0)" ::: "memory");
            const unsigned og = xb_add(&bar[XB_TOP], 1u);
            const unsigned tg = og / nx;
            if (og + 1u == (tg + 1u) * nx) xb_add(&bar[XB_TOPGEN], 1u);
            else XB_SPIN(xb_ld(&bar[XB_TOPGEN]) == tg, bar);
            __builtin_amdgcn_fence(__ATOMIC_ACQUIRE, "agent");
            xb_add(&bar[XB_XGEN(b.x)], 1u);
            asm volatile("s_waitcnt vmcnt(0)" ::: "memory");
        } else {
            XB_SPIN(xb_ld(&bar[XB_XGEN(b.x)]) == gen, bar);
            __builtin_amdgcn_fence(__ATOMIC_ACQUIRE, "agent");
            asm volatile("s_waitcnt vmcnt(0)" ::: "memory");
        }
    }
    __syncthreads();
}
struct ClsBarrier { unsigned* cnt; unsigned* gen; unsigned* tmo; unsigned n; bool same; };
__device__ __forceinline__ void cls_barrier(const ClsBarrier& c) {
    asm volatile("s_waitcnt vmcnt(0)" ::: "memory");
    __syncthreads();
    if (threadIdx.x == 0) {
        __builtin_amdgcn_s_waitcnt(0);
        if (!c.same) { __builtin_amdgcn_fence(__ATOMIC_RELEASE, "agent"); asm volatile("s_waitcnt vmcnt(0)" ::: "memory"); }
        const unsigned old = xb_add(c.cnt, 1u); const unsigned gen = old / c.n;
        if (old + 1u == (gen + 1u) * c.n) xb_add(c.gen, 1u);
        else XB_SPIN(xb_ld(c.gen) == gen, c.tmo - XB_TMO);
        __builtin_amdgcn_fence(__ATOMIC_ACQUIRE, "agent");
        asm volatile("s_waitcnt vmcnt(0)" ::: "memory");
    }
    __syncthreads();
}

struct SeamPre {
    ClsBarrier c; XcdBarrier b; bool use_cls, active; unsigned old;
    __device__ __forceinline__ void arrive() {
        if (!active) return;
        if (!use_cls) { xcd_barrier(b); return; }
        asm volatile("s_waitcnt vmcnt(0)" ::: "memory");
        __syncthreads();
        if (threadIdx.x == 0) {
            __builtin_amdgcn_s_waitcnt(0);
            if (!c.same) { __builtin_amdgcn_fence(__ATOMIC_RELEASE, "agent"); asm volatile("s_waitcnt vmcnt(0)" ::: "memory"); }
            old = xb_add(c.cnt, 1u);
        }
    }
    __device__ __forceinline__ void wait() {
        if (!active || !use_cls) return;
        if (threadIdx.x == 0) {
            const unsigned gen = old / c.n;
            if (old + 1u == (gen + 1u) * c.n) xb_add(c.gen, 1u);
            else XB_SPIN(xb_ld(c.gen) == gen, c.tmo - XB_TMO);
            __builtin_amdgcn_fence(__ATOMIC_ACQUIRE, "agent");
            asm volatile("s_waitcnt vmcnt(0)" ::: "memory");
        }
        __syncthreads();
    }
};

struct Args { const float* in[23]; float* out; unsigned char* ws; int ph_lo, ph_hi, li, pad; };

struct Frame {
    LAS unsigned char* lds;
    int tid, lane, wave, vcu, G;
    unsigned char* ws;
};

__device__ __forceinline__ int map_col(int mode, int n) {
    if (mode == 0) return n;
    if (mode == 1) {
        if (n < 1280) return n;
        if (n < 1304) return 2304 + (n - 1280);
        if (n < 1816) { const int c = n - 1304; return 1280 + (c >> 7) * 256 + (c & 127); }
        const int c = n - 1816; return 1280 + (c >> 7) * 256 + 128 + (c & 127);
    }
    if (n < FFN) return (n >> 7) * 256 + (n & 127);
    const int c = n - FFN; return (c >> 7) * 256 + 128 + (c & 127);
}
constexpr int TR_SCR = 64 * 65 * 4;
template <bool BF = false, bool SC = false>
__device__ __forceinline__ void p0_transpose_item(const float* W, int K, int N, half_t* WT, int mode, const float* sc, LAS float* scr, int item, int lane) {
    const int nblk = (N + 63) / 64, kb = item / nblk, nb = item % nblk, k0 = 64 * kb, n0 = 64 * nb;
    const int nn = n0 + (lane & 15) * 4; const bool nok = nn < N;
    f32x4 v[16]; float scv[16];
    if (SC) {
#pragma unroll
        for (int i = 0; i < 16; ++i) scv[i] = sc[k0 + 4 * i + (lane >> 4)];
    }
#pragma unroll
    for (int i = 0; i < 16; ++i) { const int kk = 4 * i + (lane >> 4); v[i] = nok ? __builtin_nontemporal_load((const f32x4*)(W + (size_t)(k0 + kk) * N + nn)) : (f32x4){0.f, 0.f, 0.f, 0.f}; }
    if (SC) {
#pragma unroll
        for (int i = 0; i < 16; ++i) v[i] *= scv[i];
    }
#pragma unroll
    for (int i = 0; i < 16; ++i) { const int kk = 4 * i + (lane >> 4); LAS float* d = scr + kk * 65 + (lane & 15) * 4; d[0] = v[i][0]; d[1] = v[i][1]; d[2] = v[i][2]; d[3] = v[i][3]; }
    asm volatile("s_waitcnt lgkmcnt(0)" ::: "memory");
    const int c = lane & 7;
#pragma unroll
    for (int j = 0; j < 8; ++j) { const int n = (lane >> 3) + 8 * j; const LAS float* s = scr + (8 * c) * 65 + n;
        u32x4 o; if (BF) { o.x = pkb(s[0 * 65], s[1 * 65]); o.y = pkb(s[2 * 65], s[3 * 65]); o.z = pkb(s[4 * 65], s[5 * 65]); o.w = pkb(s[6 * 65], s[7 * 65]); }
        else { o.x = pkh(s[0 * 65], s[1 * 65]); o.y = pkh(s[2 * 65], s[3 * 65]); o.z = pkh(s[4 * 65], s[5 * 65]); o.w = pkh(s[6 * 65], s[7 * 65]); }
        if (n0 + n < N) *(u32x4*)(WT + (size_t)map_col(mode, n0 + n) * K + k0 + 8 * c) = o; }
    asm volatile("s_waitcnt lgkmcnt(0)" ::: "memory");
}
__device__ __forceinline__ void p0_prologue(Frame& F, const Args& a, int mode = 3, int gwx = 0, int ngwx = 1) {
    LAS float* scr = (LAS float*)(F.lds + F.wave * TR_SCR);
    const int gw = (mode == 2) ? gwx : F.vcu * NWAVES + F.wave, NGW = (mode == 2) ? ngwx : F.G * NWAVES, lane = F.lane;
    const float* w_in = a.in[2]; const float* w1k = a.in[8]; const float* w1v = a.in[11];
    constexpr int I_IN = 16 * 37, I_W1 = 32 * 4;
    constexpr int NITEMS = I_IN + 2 * I_W1;
    for (int it = (mode == 2) ? I_IN + gw : gw; it < ((mode == 1) ? I_IN : NITEMS); it += NGW) {
        int r = it;
        if (r < I_IN) { p0_transpose_item<IN_BF16 != 0>(w_in, 1024, IN_W, (half_t*)(F.ws + WS_WIN), 1, nullptr, scr, r, lane); continue; } r -= I_IN;
        if (r < I_W1) { p0_transpose_item(w1k, 2048, 256, (half_t*)(F.ws + WS_W1K), 0, nullptr, scr, r, lane); continue; } r -= I_W1;
        p0_transpose_item(w1v, 2048, 256, (half_t*)(F.ws + WS_W1V), 0, nullptr, scr, r, lane);
    }
    if (mode & 1) {
        const float* x = a.in[0]; const float* g = a.in[1]; half_t* XN = (half_t*)(F.ws + WS_XN);
        f32x4 gv[4];
#pragma unroll
        for (int j = 0; j < 4; ++j) gv[j] = *(const f32x4*)(g + 4 * lane + 256 * j);
        for (int m = gw; m < M; m += 2 * NGW) {
            const int m2 = m + NGW;
            const f32x4* xr = (const f32x4*)(x + (size_t)m * D_MODEL) + lane; const f32x4* xr2 = (const f32x4*)(x + (size_t)m2 * D_MODEL) + lane; f32x4 v[4], w[4]; float s = 0.f, s2 = 0.f;
#pragma unroll
            for (int j = 0; j < 4; ++j) { v[j] = __builtin_nontemporal_load(xr + 64 * j); w[j] = __builtin_nontemporal_load(xr2 + 64 * j); }
#pragma unroll
            for (int j = 0; j < 4; ++j) { s += (v[j][0] * v[j][0] + v[j][1] * v[j][1]) + (v[j][2] * v[j][2] + v[j][3] * v[j][3]); s2 += (w[j][0] * w[j][0] + w[j][1] * w[j][1]) + (w[j][2] * w[j][2] + w[j][3] * w[j][3]); }
            const float r = 1.0f / sqrtf(wave_sum(s) * (1.0f / D_MODEL) + EPS), r2 = 1.0f / sqrtf(wave_sum(s2) * (1.0f / D_MODEL) + EPS);
            u32x2* o8 = (u32x2*)(XN + (size_t)m * D_MODEL) + lane; u32x2* o82 = (u32x2*)(XN + (size_t)m2 * D_MODEL) + lane;
#pragma unroll
            for (int j = 0; j < 4; ++j) { u32x2 t; t.x = PKI(v[j][0] * r * gv[j][0], v[j][1] * r * gv[j][1]); t.y = PKI(v[j][2] * r * gv[j][2], v[j][3] * r * gv[j][3]); o8[64 * j] = t;
                u32x2 t2; t2.x = PKI(w[j][0] * r2 * gv[j][0], w[j][1] * r2 * gv[j][1]); t2.y = PKI(w[j][2] * r2 * gv[j][2], w[j][3] * r2 * gv[j][3]); o82[64 * j] = t2; }
        }
    }
    if (!(mode & 2)) return;
    {
        float* RC = (float*)(F.ws + WS_ROPEC); float* RS = (float*)(F.ws + WS_ROPES);
        for (int e = gw * 64 + lane; e < SEQ * 32; e += NGW * 64) { const int pos = e >> 5, i = e & 31;
            const float inv = exp2f(-(float)i * (13.287712379549449f / 32.0f)); const float ang = (float)pos * inv; float sn, cs; sincosf(ang, &sn, &cs); RC[e] = cs; RS[e] = sn; }
    }
    if (gw == 0) { float gs = fabsf(a.in[5][lane]), gw_ = fabsf(a.in[6][lane]), gc_ = fabsf(a.in[4][lane]);
#pragma unroll
        for (int o = 1; o < 64; o <<= 1) { gs = fmaxf(gs, __shfl_xor(gs, o)); gw_ = fmaxf(gw_, __shfl_xor(gw_, o)); gc_ = fmaxf(gc_, __shfl_xor(gc_, o)); }
        if (lane == 0) { float* GM = (float*)(F.ws + WS_GMAX); GM[0] = gs; GM[1] = gw_; GM[2] = gc_; } }
    {
        float* BP = (float*)(F.ws + WS_BIASP);
        const bool spread = (NGW == 2048);
        for (int it = spread ? ((gw & 15) == 0 ? (gw >> 4) : 128) : gw; it < 16 * 2 * 4; it += spread ? 128 : NGW) { const int seg = it >> 3, kv = (it >> 2) & 1, jb = it & 3, j = jb * 64 + lane;
            const float* pe = (kv ? a.in[10] : a.in[7]) + seg * 128; const float* w1 = (kv ? a.in[11] : a.in[8]) + (size_t)(seg * 128) * CMP_HID + j; float s = 0.f;
#pragma unroll 1
            for (int r0 = 0; r0 < 128; r0 += 32) { float pv[32], wv[32];
#pragma unroll
                for (int r = 0; r < 32; ++r) { pv[r] = pe[r0 + r]; wv[r] = w1[(size_t)(r0 + r) * CMP_HID]; }
#pragma unroll
                for (int r = 0; r < 32; ++r) s += pv[r] * wv[r]; }
            BP[(seg * 2 + kv) * CMP_HID + j] = s; }
    }
}

__device__ __forceinline__ void late_weights(Frame& F, const Args& a, int wi, int nw, int lo, int hi) {
    LAS float* scr = (LAS float*)(F.lds + F.wave * TR_SCR);
    const float* w_out = a.in[19]; const float* w_gu = a.in[21]; const float* w_dn = a.in[22];
    constexpr int I_OUT = 16 * 16, I_GU = 16 * 88, I_DN = 44 * 16;
    if (hi > I_OUT + I_GU + I_DN) hi = I_OUT + I_GU + I_DN;
    for (int it = lo + wi; it < hi; it += nw) {
        int r = it;
        if (r < I_OUT) { p0_transpose_item<MIX_BF16 != 0>(w_out, 1024, 1024, (half_t*)(F.ws + WS_WOUT), 0, nullptr, scr, r, F.lane); continue; } r -= I_OUT;
        if (r < I_GU) { p0_transpose_item<FFN_BF16 != 0, true>(w_gu, 1024, 2 * FFN, (half_t*)(F.ws + WS_WGU), 2, a.in[20], scr, r, F.lane); continue; } r -= I_GU;
        p0_transpose_item<FFN_BF16 != 0>(w_dn, FFN, 1024, (half_t*)(F.ws + WS_WDN), 0, nullptr, scr, r, F.lane);
    }
}
__device__ __forceinline__ void conv_half(Frame& F, const Args& a, int hidx) {
    const int item = hidx >> 1, jh = hidx & 1;
    const int c = F.tid, r0 = item * 64, b = r0 >> 11, tl0 = r0 & 2047, lane = F.lane;
    const half_t* HCV = (const half_t*)(F.ws + WS_HCV); half_t* MIX = (half_t*)(F.ws + WS_MIX);
    const float* cw = a.in[13];
    LAS half_t* X = (LAS half_t*)F.lds;
    LAS float* Y = (LAS float*)(F.lds + 65536);
    float w[31];
#pragma unroll
    for (int k = 0; k < 31; ++k) w[k] = cw[k * CONV_CH + c];
    const float bias = a.in[14][c];
    const float* lg = a.in[15]; const float* lb = a.in[16]; const float* og = a.in[18];
    {
        u32x4 st[8];
#pragma unroll
        for (int k = 0; k < 8; ++k) { const int id = c + 512 * k, rr = id >> 6, cc = id & 63, tl = tl0 - 30 + 32 * jh + rr;
            st[k] = (rr < 62 && tl >= 0) ? *(const u32x4*)(HCV + (size_t)(b * SEQ + tl) * CONV_CH + cc * 8) : (u32x4){0u, 0u, 0u, 0u}; }
#pragma unroll
        for (int k = 0; k < 8; ++k) { const int id = c + 512 * k; if ((id >> 6) < 62) *(LAS u32x4*)(X + id * 8) = st[k]; }
        __syncthreads();
        typedef float f32p __attribute__((ext_vector_type(2)));
#pragma unroll 1
        for (int hh = 0; hh < 2; ++hh) {
            f32p xe[23], xo[22];
#pragma unroll
            for (int i = 0; i < 23; ++i) { xe[i][0] = (float)X[(16 * hh + 2 * i) * CONV_CH + c]; xe[i][1] = (float)X[(16 * hh + 2 * i + 1) * CONV_CH + c]; }
#pragma unroll
            for (int i = 0; i < 22; ++i) { xo[i][0] = xe[i][1]; xo[i][1] = xe[i + 1][0]; }
#pragma unroll
            for (int jp = 0; jp < 8; ++jp) { f32p y = {bias, bias};
#pragma unroll
                for (int k = 0; k < 31; ++k) { const int p = 2 * jp + k; const f32p xv = (p & 1) ? xo[(p - 1) >> 1] : xe[p >> 1]; const f32p wk = {w[k], w[k]}; y = __builtin_elementwise_fma(wk, xv, y); }
                Y[(16 * hh + 2 * jp) * CONV_CH + c] = y[0]; Y[(16 * hh + 2 * jp + 1) * CONV_CH + c] = y[1]; }
        }
        float g8[8], b8[8], o8[8];
#pragma unroll
        for (int i = 0; i < 8; ++i) { g8[i] = lg[lane * 8 + i]; b8[i] = lb[lane * 8 + i]; o8[i] = og[lane * 8 + i]; }
        __syncthreads();
        {
            float v[4][8], s4[4], q4[4], ss4[4];
#pragma unroll
            for (int jj = 0; jj < 4; ++jj) { const int j = F.wave * 4 + jj;
                const f32x4 va = *(const LAS f32x4*)(Y + j * CONV_CH + lane * 8), vb = *(const LAS f32x4*)(Y + j * CONV_CH + lane * 8 + 4);
                v[jj][0] = va[0]; v[jj][1] = va[1]; v[jj][2] = va[2]; v[jj][3] = va[3]; v[jj][4] = vb[0]; v[jj][5] = vb[1]; v[jj][6] = vb[2]; v[jj][7] = vb[3];
                float t = 0.f;
#pragma unroll
                for (int i = 0; i < 8; ++i) t += v[jj][i];
                s4[jj] = t; }
#pragma unroll
            for (int jj = 0; jj < 4; ++jj) s4[jj] = wave_sum(s4[jj]);
#pragma unroll
            for (int jj = 0; jj < 4; ++jj) { const float mean = s4[jj] * (1.0f / CONV_CH); float q = 0.f;
#pragma unroll
                for (int i = 0; i < 8; ++i) { v[jj][i] -= mean; q += v[jj][i] * v[jj][i]; }
                q4[jj] = q; }
#pragma unroll
            for (int jj = 0; jj < 4; ++jj) q4[jj] = wave_sum(q4[jj]);
#pragma unroll
            for (int jj = 0; jj < 4; ++jj) { const float rstd = 1.0f / sqrtf(q4[jj] * (1.0f / CONV_CH) + EPS); float ss = 0.f;
#pragma unroll
                for (int i = 0; i < 8; ++i) { const float hn = v[jj][i] * rstd * g8[i] + b8[i]; const float sl = hn * sigmoidf_(hn); v[jj][i] = sl; ss += sl * sl; }
                ss4[jj] = ss; }
#pragma unroll
            for (int jj = 0; jj < 4; ++jj) ss4[jj] = wave_sum(ss4[jj]);
#pragma unroll
            for (int jj = 0; jj < 4; ++jj) { const int j = F.wave * 4 + jj; const float r2 = 1.0f / sqrtf(ss4[jj] * (1.0f / CONV_CH) + EPS);
                u32x4 wv; wv.x = PKM(v[jj][0] * r2 * o8[0], v[jj][1] * r2 * o8[1]); wv.y = PKM(v[jj][2] * r2 * o8[2], v[jj][3] * r2 * o8[3]); wv.z = PKM(v[jj][4] * r2 * o8[4], v[jj][5] * r2 * o8[5]); wv.w = PKM(v[jj][6] * r2 * o8[6], v[jj][7] * r2 * o8[7]);
                *(u32x4*)(MIX + (size_t)(r0 + 32 * jh + j) * D_MODEL + NSA_W + lane * 8) = wv; }
        }
        __syncthreads();
    }
}
__device__ __forceinline__ void conv_halves(Frame& F, const Args& a, int hidx0, int nh) {
    const int c = F.tid, lane = F.lane;
    const half_t* HCV = (const half_t*)(F.ws + WS_HCV); half_t* MIX = (half_t*)(F.ws + WS_MIX);
    const float* cw = a.in[13];
    LAS half_t* X = (LAS half_t*)F.lds;
    LAS float* Y = (LAS float*)(F.lds + 65536);
    float w[31];
#pragma unroll
    for (int k = 0; k < 31; ++k) w[k] = cw[k * CONV_CH + c];
    const float bias = a.in[14][c];
    const float* lg = a.in[15]; const float* lb = a.in[16]; const float* og = a.in[18];
    u32x4 st[8];
    auto fetch = [&](int hidx) { const int item = hidx >> 1, jh = hidx & 1, r0 = item * 64, b = r0 >> 11, tl0 = r0 & 2047;
#pragma unroll
        for (int k = 0; k < 8; ++k) { const int id = c + 512 * k, rr = id >> 6, cc = id & 63, tl = tl0 - 30 + 32 * jh + rr;
            st[k] = (rr < 62 && tl >= 0) ? *(const u32x4*)(HCV + (size_t)(b * SEQ + tl) * CONV_CH + cc * 8) : (u32x4){0u, 0u, 0u, 0u}; } };
    fetch(hidx0);
#pragma unroll 1
    for (int ih = 0; ih < nh; ++ih) {
        const int hidx = hidx0 + ih, item = hidx >> 1, jh = hidx & 1, r0 = item * 64;
#pragma unroll
        for (int k = 0; k < 8; ++k) { const int id = c + 512 * k; if ((id >> 6) < 62) *(LAS u32x4*)(X + id * 8) = st[k]; }
        __syncthreads();
        if (ih + 1 < nh) fetch(hidx + 1);
        typedef float f32p __attribute__((ext_vector_type(2)));
#pragma unroll 1
        for (int hh = 0; hh < 2; ++hh) {
            f32p xe[23], xo[22];
#pragma unroll
            for (int i = 0; i < 23; ++i) { xe[i][0] = (float)X[(16 * hh + 2 * i) * CONV_CH + c]; xe[i][1] = (float)X[(16 * hh + 2 * i + 1) * CONV_CH + c]; }
#pragma unroll
            for (int i = 0; i < 22; ++i) { xo[i][0] = xe[i][1]; xo[i][1] = xe[i + 1][0]; }
#pragma unroll
            for (int jp = 0; jp < 8; ++jp) { f32p y = {bias, bias};
#pragma unroll
                for (int k = 0; k < 31; ++k) { const int p = 2 * jp + k; const f32p xv = (p & 1) ? xo[(p - 1) >> 1] : xe[p >> 1]; const f32p wk = {w[k], w[k]}; y = __builtin_elementwise_fma(wk, xv, y); }
                Y[(16 * hh + 2 * jp) * CONV_CH + c] = y[0]; Y[(16 * hh + 2 * jp + 1) * CONV_CH + c] = y[1]; }
        }
        float g8[8], b8[8], o8[8];
#pragma unroll
        for (int i = 0; i < 8; ++i) { g8[i] = lg[lane * 8 + i]; b8[i] = lb[lane * 8 + i]; o8[i] = og[lane * 8 + i]; }
        __syncthreads();
        {
            float v[4][8], s4[4], q4[4], ss4[4];
#pragma unroll
            for (int jj = 0; jj < 4; ++jj) { const int j = F.wave * 4 + jj;
                const f32x4 va = *(const LAS f32x4*)(Y + j * CONV_CH + lane * 8), vb = *(const LAS f32x4*)(Y + j * CONV_CH + lane * 8 + 4);
                v[jj][0] = va[0]; v[jj][1] = va[1]; v[jj][2] = va[2]; v[jj][3] = va[3]; v[jj][4] = vb[0]; v[jj][5] = vb[1]; v[jj][6] = vb[2]; v[jj][7] = vb[3];
                float t = 0.f;
#pragma unroll
                for (int i = 0; i < 8; ++i) t += v[jj][i];
                s4[jj] = t; }
#pragma unroll
            for (int jj = 0; jj < 4; ++jj) s4[jj] = wave_sum(s4[jj]);
#pragma unroll
            for (int jj = 0; jj < 4; ++jj) { const float mean = s4[jj] * (1.0f / CONV_CH); float q = 0.f;
#pragma unroll
                for (int i = 0; i < 8; ++i) { v[jj][i] -= mean; q += v[jj][i] * v[jj][i]; }
                q4[jj] = q; }
#pragma unroll
            for (int jj = 0; jj < 4; ++jj) q4[jj] = wave_sum(q4[jj]);
#pragma unroll
            for (int jj = 0; jj < 4; ++jj) { const float rstd = 1.0f / sqrtf(q4[jj] * (1.0f / CONV_CH) + EPS); float ss = 0.f;
#pragma unroll
                for (int i = 0; i < 8; ++i) { const float hn = v[jj][i] * rstd * g8[i] + b8[i]; const float sl = hn * sigmoidf_(hn); v[jj][i] = sl; ss += sl * sl; }
                ss4[jj] = ss; }
#pragma unroll
            for (int jj = 0; jj < 4; ++jj) ss4[jj] = wave_sum(ss4[jj]);
#pragma unroll
            for (int jj = 0; jj < 4; ++jj) { const int j = F.wave * 4 + jj; const float r2 = 1.0f / sqrtf(ss4[jj] * (1.0f / CONV_CH) + EPS);
                u32x4 wv; wv.x = PKM(v[jj][0] * r2 * o8[0], v[jj][1] * r2 * o8[1]); wv.y = PKM(v[jj][2] * r2 * o8[2], v[jj][3] * r2 * o8[3]); wv.z = PKM(v[jj][4] * r2 * o8[4], v[jj][5] * r2 * o8[5]); wv.w = PKM(v[jj][6] * r2 * o8[6], v[jj][7] * r2 * o8[7]);
                *(u32x4*)(MIX + (size_t)(r0 + 32 * jh + j) * D_MODEL + NSA_W + lane * 8) = wv; }
        }
        __syncthreads();
    }
}
__device__ __forceinline__ void conv_item(Frame& F, const Args& a, int item) { conv_half(F, a, 2 * item); conv_half(F, a, 2 * item + 1); }
struct KPrepRow { h8 r1, r2; f32x4 c0, c1, s0, s1, g0, g1, g2, g3; half_t* dst; };
__device__ __forceinline__ void kprep(Frame& F, const Args& a, int gw, int NGW) {
    const int lane = F.lane, l4 = lane & 3, sub = lane >> 2;
    const float* RC = (const float*)(F.ws + WS_ROPEC); const float* RS = (const float*)(F.ws + WS_ROPES);
    constexpr int NROWB = (2 * BATCH * NG * SEQ) / 16;
    auto load = [&](int rb, KPrepRow& p) {
        const int rowg = rb * 16 + sub; const int which = rowg >= BATCH * NG * SEQ; const int row = rowg - which * BATCH * NG * SEQ; const int t = row & 2047;
        const half_t* src = (const half_t*)(F.ws + (which ? WS_KWR : WS_KSR)) + (size_t)row * HD; p.dst = (half_t*)(F.ws + (which ? WS_KW : WS_KS)) + (size_t)row * HD;
        const float* gn = which ? a.in[6] : a.in[5];
        p.r1 = *(const h8*)(src + 8 * l4); p.r2 = *(const h8*)(src + 32 + 8 * l4);
        p.c0 = *(const f32x4*)(RC + t * 32 + 8 * l4); p.c1 = *(const f32x4*)(RC + t * 32 + 8 * l4 + 4); p.s0 = *(const f32x4*)(RS + t * 32 + 8 * l4); p.s1 = *(const f32x4*)(RS + t * 32 + 8 * l4 + 4);
        p.g0 = *(const f32x4*)(gn + 8 * l4); p.g1 = *(const f32x4*)(gn + 8 * l4 + 4); p.g2 = *(const f32x4*)(gn + 32 + 8 * l4); p.g3 = *(const f32x4*)(gn + 32 + 8 * l4 + 4); };
    auto finish = [&](const KPrepRow& p) {
        float v1[8], v2[8]; float ss = 0.f;
#pragma unroll
        for (int i = 0; i < 8; ++i) { v1[i] = (float)p.r1[i]; v2[i] = (float)p.r2[i]; ss += v1[i] * v1[i] + v2[i] * v2[i]; }
        ss += __shfl_xor(ss, 1); ss += __shfl_xor(ss, 2);
        const float r = 1.0f / sqrtf(ss * (1.0f / HD) + EPS);
        float o1[8], o2[8];
#pragma unroll
        for (int i = 0; i < 8; ++i) { const float cs = i < 4 ? p.c0[i & 3] : p.c1[i & 3], sn = i < 4 ? p.s0[i & 3] : p.s1[i & 3], ga = i < 4 ? p.g0[i & 3] : p.g1[i & 3], gb = i < 4 ? p.g2[i & 3] : p.g3[i & 3];
            const float x1 = v1[i] * r * ga, x2 = v2[i] * r * gb; o1[i] = x1 * cs - x2 * sn; o2[i] = x2 * cs + x1 * sn; }
        u32x4 w1; w1.x = pkh(o1[0], o1[1]); w1.y = pkh(o1[2], o1[3]); w1.z = pkh(o1[4], o1[5]); w1.w = pkh(o1[6], o1[7]);
        u32x4 w2; w2.x = pkh(o2[0], o2[1]); w2.y = pkh(o2[2], o2[3]); w2.z = pkh(o2[4], o2[5]); w2.w = pkh(o2[6], o2[7]);
        *(u32x4*)(p.dst + 8 * l4) = w1; *(u32x4*)(p.dst + 32 + 8 * l4) = w2; };
    for (int rb = gw; rb < NROWB; rb += 2 * NGW) {
        KPrepRow pa, pb; const bool two = rb + NGW < NROWB;
        load(rb, pa); if (two) load(rb + NGW, pb);
        finish(pa); if (two) finish(pb);
    }
}
template <bool W2_LDS>
__device__ __forceinline__ void cmp_finalize(Frame& F, const Args& a, int it0, int its, int it1, int kv_wg) {
    const int lane = F.lane;
    const float* BP = (const float*)(F.ws + WS_BIASP); const float* HIDP = (const float*)(F.ws + WS_HIDP);
    const float* RC = (const float*)(F.ws + WS_ROPEC); const float* RS = (const float*)(F.ws + WS_ROPES);
    LAS float* W2L = (LAS float*)F.lds; constexpr bool w2_lds = W2_LDS;
    if (w2_lds) { const float* w2g = kv_wg ? a.in[12] : a.in[9];
#pragma unroll
        for (int k = 0; k < 8; ++k) { const int id = F.tid + 512 * k; *(LAS f32x4*)(W2L + id * 4) = *(const f32x4*)(w2g + id * 4); }
        __syncthreads(); }
    for (int it = it0; it < it1; it += its) {
        const int kv = it >> 10, row = (it & 1023) * 2, n = row & 127;
        f32x4 bias = {0.f, 0.f, 0.f, 0.f};
#pragma unroll
        for (int seg = 0; seg < 16; ++seg) bias += *(const f32x4*)(BP + (seg * 2 + kv) * CMP_HID + 4 * lane);
        f32x4 hv0 = bias, hv1 = bias;
#pragma unroll
        for (int ks = 0; ks < 8; ++ks) { const float* hp = HIDP + ((size_t)(kv * 8 + ks) * 2048 + row) * CMP_HID + 4 * lane; hv0 += *(const f32x4*)hp; hv1 += *(const f32x4*)(hp + CMP_HID); }
        float hs0[4], hs1[4];
#pragma unroll
        for (int i = 0; i < 4; ++i) { hs0[i] = hv0[i] * sigmoidf_(hv0[i]); hs1[i] = hv1[i] * sigmoidf_(hv1[i]); }
        const float* w2 = (kv ? a.in[12] : a.in[9]) + lane; float o0 = 0.f, o1 = 0.f;
#pragma unroll 2
        for (int jl = 0; jl < 64; ++jl) {
            float w[4];
#pragma unroll
            for (int i = 0; i < 4; ++i) w[i] = w2_lds ? W2L[(jl * 4 + i) * HD + lane] : w2[(jl * 4 + i) * HD];
#pragma unroll
            for (int i = 0; i < 4; ++i) { const float b0 = __int_as_float(__builtin_amdgcn_readlane(__float_as_int(hs0[i]), jl)), b1 = __int_as_float(__builtin_amdgcn_readlane(__float_as_int(hs1[i]), jl));
                o0 = __builtin_fmaf(b0, w[i], o0); o1 = __builtin_fmaf(b1, w[i], o1); }
        }
        half_t* dst = (half_t*)(F.ws + (kv ? WS_VCMP : WS_KCMP)) + (size_t)row * HD + lane;
        if (kv == 0) {
            const float gk = a.in[4][lane]; const int i = lane & 31;
            { const float r = 1.0f / sqrtf(wave_sum(o0 * o0) * (1.0f / HD) + EPS); const float xn = o0 * r * gk; const float other = __shfl_xor(xn, 32); const int pos = 16 * n + 31; const float cs = RC[pos * 32 + i], sn = RS[pos * 32 + i];
              o0 = lane < 32 ? xn * cs - other * sn : xn * cs + other * sn; }
            { const float r = 1.0f / sqrtf(wave_sum(o1 * o1) * (1.0f / HD) + EPS); const float xn = o1 * r * gk; const float other = __shfl_xor(xn, 32); const int pos = 16 * (n + 1) + 31; const float cs = RC[(pos & 2047) * 32 + i], sn = RS[(pos & 2047) * 32 + i];
              o1 = lane < 32 ? xn * cs - other * sn : xn * cs + other * sn; }
        }
        dst[0] = (half_t)o0;
        dst[HD] = (n + 1 == NCMP) ? (half_t)0.f : (half_t)o1;
    }
}

template <class Wait>
__device__ __forceinline__ void cmp_finalize_wg(Frame& F, const Args& a, int it_base, int kv, Wait wait) {
    const int lane = F.lane, tid = F.tid, wave = F.wave;
    const float* BP = (const float*)(F.ws + WS_BIASP); const float* HIDP = (const float*)(F.ws + WS_HIDP);
    const float* RC = (const float*)(F.ws + WS_ROPEC); const float* RS = (const float*)(F.ws + WS_ROPES);
    constexpr int LDH = 264;
    LAS half_t* W2T = (LAS half_t*)F.lds;
    LAS half_t* Hs = (LAS half_t*)(F.lds + 34816);
    LAS float* Os = (LAS float*)(F.lds + 53248);
    const float* w2g = kv ? a.in[12] : a.in[9];
    f32x4 wv[8];
#pragma unroll
    for (int q = 0; q < 8; ++q) wv[q] = *(const f32x4*)(w2g + (tid + 512 * q) * 4);
    f32x4 hv[2][2]; f32x4 bias = {0.f, 0.f, 0.f, 0.f};
#pragma unroll
    for (int seg = 0; seg < 16; ++seg) bias += *(const f32x4*)(BP + (seg * 2 + kv) * CMP_HID + 4 * lane);
    wait();
#pragma unroll
    for (int ii = 0; ii < 2; ++ii) { const int il = wave + 8 * ii, it = it_base + il, row = (it & 1023) * 2;
        f32x4 h0 = bias, h1 = bias;
#pragma unroll
        for (int ks = 0; ks < 8; ++ks) { const float* hp = HIDP + ((size_t)(kv * 8 + ks) * 2048 + row) * CMP_HID + 4 * lane; h0 += *(const f32x4*)hp; h1 += *(const f32x4*)(hp + CMP_HID); }
        hv[ii][0] = h0; hv[ii][1] = h1; }
#pragma unroll
    for (int q = 0; q < 8; ++q) { const int id = tid + 512 * q, k = id >> 4, d0 = (id & 15) * 4;
#pragma unroll
        for (int i = 0; i < 4; ++i) W2T[(d0 + i) * LDH + k] = (half_t)wv[q][i]; }
#pragma unroll
    for (int ii = 0; ii < 2; ++ii)
#pragma unroll
        for (int rr = 0; rr < 2; ++rr) { const f32x4 h = hv[ii][rr]; u32x2 w; w.x = pkh(h[0] * sigmoidf_(h[0]), h[1] * sigmoidf_(h[1])); w.y = pkh(h[2] * sigmoidf_(h[2]), h[3] * sigmoidf_(h[3]));
            *(LAS u32x2*)(Hs + (2 * (wave + 8 * ii) + rr) * LDH + 4 * lane) = w; }
    __syncthreads();
    {
        const int mb = wave & 1, nb = wave >> 1, r = lane & 15, kq = lane >> 4; f32x4 acc = {0.f, 0.f, 0.f, 0.f};
#pragma unroll
        for (int ks = 0; ks < 8; ++ks) { const h8 af = *(const LAS h8*)(Hs + (mb * 16 + r) * LDH + 32 * ks + 8 * kq), bf = *(const LAS h8*)(W2T + (nb * 16 + r) * LDH + 32 * ks + 8 * kq);
            acc = __builtin_amdgcn_mfma_f32_16x16x32_f16(af, bf, acc, 0, 0, 0); }
#pragma unroll
        for (int i = 0; i < 4; ++i) Os[(mb * 16 + 4 * kq + i) * 65 + nb * 16 + r] = acc[i];
    }
    __syncthreads();
#pragma unroll
    for (int ii = 0; ii < 2; ++ii) { const int il = wave + 8 * ii, it = it_base + il, row = (it & 1023) * 2, n = row & 127;
        float o0 = Os[(2 * il) * 65 + lane], o1 = Os[(2 * il + 1) * 65 + lane];
        half_t* dst = (half_t*)(F.ws + (kv ? WS_VCMP : WS_KCMP)) + (size_t)row * HD + lane;
        if (kv == 0) {
            const float gk = a.in[4][lane]; const int i = lane & 31;
            { const float r = 1.0f / sqrtf(wave_sum(o0 * o0) * (1.0f / HD) + EPS); const float xn = o0 * r * gk; const float other = __shfl_xor(xn, 32); const int pos = 16 * n + 31; const float cs = RC[pos * 32 + i], sn = RS[pos * 32 + i];
              o0 = lane < 32 ? xn * cs - other * sn : xn * cs + other * sn; }
            { const float r = 1.0f / sqrtf(wave_sum(o1 * o1) * (1.0f / HD) + EPS); const float xn = o1 * r * gk; const float other = __shfl_xor(xn, 32); const int pos = 16 * (n + 1) + 31; const float cs = RC[(pos & 2047) * 32 + i], sn = RS[(pos & 2047) * 32 + i];
              o1 = lane < 32 ? xn * cs - other * sn : xn * cs + other * sn; }
        }
        dst[0] = (half_t)o0;
        dst[HD] = (n + 1 == NCMP) ? (half_t)0.f : (half_t)o1;
    }
    __syncthreads();
}

constexpr int A_CMPK = 0, A_CMPV = 32768, A_IMP = 65536, A_KS0 = 98304, A_KS1 = 114688, A_VS0 = 81920, A_VS1 = 65536, A_SSQ = 131072, A_OT = 0;
__device__ __forceinline__ int crow(int r, int hi) { return (r & 3) + 8 * (r >> 2) + 4 * hi; }
__device__ __forceinline__ s16x4 vtr(const LAS unsigned char* p) { return __builtin_bit_cast(s16x4, __builtin_amdgcn_ds_read_tr16_b64_v4i16((LAS s16x4*)p)); }
#define MFMA32(a, b, c) __builtin_amdgcn_mfma_f32_32x32x16_f16(a, b, c, 0, 0, 0)
__device__ __forceinline__ float xmax32(float v) { auto r = __builtin_amdgcn_permlane32_swap(__float_as_uint(v), __float_as_uint(v), false, false); return fmaxf(__uint_as_float(r[0]), __uint_as_float(r[1])); }
__device__ __forceinline__ float xsum32(float v) { auto r = __builtin_amdgcn_permlane32_swap(__float_as_uint(v), __float_as_uint(v), false, false); return __uint_as_float(r[0]) + __uint_as_float(r[1]); }
__device__ __forceinline__ float xget32(float v, int hi) { auto r = __builtin_amdgcn_permlane32_swap(__float_as_uint(v), __float_as_uint(v), false, false); return __uint_as_float(hi ? r[0] : r[1]); }

__device__ __forceinline__ f32x16 qk_lds(const LAS unsigned char* Kt, const h8 (&qf)[4], int r32, int hi) {
    f32x16 s = {};
    const LAS unsigned char* kp = Kt + r32 * 128; const int sw = (r32 >> 1) & 7;
#pragma unroll
    for (int d0 = 0; d0 < 4; ++d0) { const h8 kf = *(const LAS h8*)(kp + (((2 * d0 + hi) ^ sw) << 4)); s = MFMA32(kf, qf[d0], s); }
    return s;
}
__device__ __forceinline__ void pv_lds(f32x16 (&o)[2], const f32x16& p, const LAS unsigned char* Vt, int vb) {
#pragma unroll
    for (int s = 0; s < 2; ++s) {
        u32x4 pw; pw.x = pkh(p[8 * s + 0], p[8 * s + 1]); pw.y = pkh(p[8 * s + 2], p[8 * s + 3]); pw.z = pkh(p[8 * s + 4], p[8 * s + 5]); pw.w = pkh(p[8 * s + 6], p[8 * s + 7]);
        const h8 pf = __builtin_bit_cast(h8, pw);
#pragma unroll
        for (int dh = 0; dh < 2; ++dh) {
            const s16x4 lo = vtr(Vt + vb + dh * 2048 + s * 1024), hi4 = vtr(Vt + vb + dh * 2048 + s * 1024 + 512);
            const h8 vf = __builtin_bit_cast(h8, __builtin_shufflevector(lo, hi4, 0, 1, 2, 3, 4, 5, 6, 7));
            o[dh] = MFMA32(vf, pf, o[dh]);
        }
    }
}

__device__ __forceinline__ void attn_item(Frame& F, const Args& a, int b, int qt) {
    int tid = F.tid; asm volatile("" : "+v"(tid));
    const int lane = tid & 63, h = F.wave, g = h >> 2, r32 = lane & 31, hi = lane >> 5;
    const int t0 = qt * 32, t = t0 + r32, cur = qt >> 1;
    const size_t row = (size_t)b * SEQ + t;
    LAS unsigned char* lds = F.lds;
    LAS float* IMP = (LAS float*)(lds + A_IMP); LAS float* SSQ8 = (LAS float*)(lds + A_SSQ);
    const float* RC = (const float*)(F.ws + WS_ROPEC); const float* RS = (const float*)(F.ws + WS_ROPES);
    const int tg = tid >> 8, tkey = (tid >> 3) & 31, tc = tid & 7;
    const int kdst0 = tkey * 128 + ((tc ^ ((tkey >> 1) & 7)) << 4), vdst0 = (tc >> 2) * 2048 + tkey * 64 + (tc & 3) * 16;
    const int vb = (4 * hi + ((lane & 15) >> 2)) * 64 + ((lane >> 4) & 1) * 32 + (lane & 3) * 8;
    const int ntile = (qt >> 4) + 1;
    float m_sf, m_wf; bool fast = true; volatile LAS unsigned* const SLOWF = (volatile LAS unsigned*)(F.lds + MISC_OFF) + 12;
    h8 qf[4]; f32x16 ot[2]; unsigned sel; u32x4 kr0, kr1, vr0, vr1, vq0, vq1; float m_c; unsigned ma, mb; bool fastw; float qn2 = 0.f;
    const float* gt = (const float*)(F.ws + WS_GATES) + row * 24 + 3 * h;
    const float g_c = gt[0];
    const int n_s = cur + 1, kt0w = cur >= 8 ? cur - 8 : 0, nsteps = n_s + (cur - kt0w + 1);
    const unsigned kofb = (unsigned)((((b * 2 + tg) * SEQ + tkey) * HD + tc * 8) * 2);
#define ATT_TILE_BASE(wsoff_s, wsoff_w, i) (F.ws + ((i) < n_s ? (size_t)(wsoff_s) + (size_t)(i) * (64 * HD * 2) : (size_t)(wsoff_w) + (size_t)(kt0w + (i) - n_s) * (64 * HD * 2)))
#ifndef DUP_ATT_PRE
#define DUP_ATT_PRE 0
#endif
#pragma unroll 1
    for (int rep_ = 0; rep_ < (DUP_ATT_PRE ? 2 : 1); ++rep_) {
    {
        const size_t coff = ((size_t)((b * 2 + tg) * NCMP_PAD + tkey)) * HD + tc * 8;
        const half_t* Kc = (const half_t*)(F.ws + WS_KCMP) + coff; const half_t* Vc = (const half_t*)(F.ws + WS_VCMP) + coff;
        u32x4 kr[4], vr[4];
#pragma unroll
        for (int T = 0; T < 4; ++T) { kr[T] = *(const u32x4*)(Kc + T * 32 * HD); vr[T] = *(const u32x4*)(Vc + T * 32 * HD); }
        const half_t* Qp = (const half_t*)(F.ws + WS_Q) + row * NSA_W + h * HD; const float* qg = a.in[3]; const float* GM = (const float*)(F.ws + WS_GMAX);
        h8 qraw[4]; f32x4 qgv[4][2], rcv[2][2], rsv[2][2];
#pragma unroll
        for (int d0 = 0; d0 < 4; ++d0) { qraw[d0] = *(const h8*)(Qp + 16 * d0 + 8 * hi); qgv[d0][0] = *(const f32x4*)(qg + 16 * d0 + 8 * hi); qgv[d0][1] = *(const f32x4*)(qg + 16 * d0 + 8 * hi + 4); }
#pragma unroll
        for (int d0 = 0; d0 < 2; ++d0) { const int i0 = t * 32 + 16 * d0 + 8 * hi; rcv[d0][0] = *(const f32x4*)(RC + i0); rcv[d0][1] = *(const f32x4*)(RC + i0 + 4); rsv[d0][0] = *(const f32x4*)(RS + i0); rsv[d0][1] = *(const f32x4*)(RS + i0 + 4); }
        const float gm0 = GM[0], gm1 = GM[1], gm2 = GM[2];
        { const unsigned char* k0p = ATT_TILE_BASE(WS_KS, WS_KW, 0); const unsigned char* k1p = ATT_TILE_BASE(WS_KS, WS_KW, 1);
          kr0 = *(const u32x4*)(k0p + kofb); kr1 = *(const u32x4*)(k0p + 4096 + kofb); vr0 = *(const u32x4*)(k1p + kofb); vr1 = *(const u32x4*)(k1p + 4096 + kofb);
          const unsigned char* v0p = ATT_TILE_BASE(WS_VS, WS_VW, 0); vq0 = *(const u32x4*)(v0p + kofb); vq1 = *(const u32x4*)(v0p + 4096 + kofb); }
#pragma unroll
        for (int T = 0; T < 4; ++T) { *(LAS u32x4*)(lds + A_CMPK + tg * 16384 + T * 4096 + kdst0) = kr[T]; *(LAS u32x4*)(lds + A_CMPV + tg * 16384 + T * 4096 + vdst0) = vr[T]; }
        float qv[4][8]; float ss = 0.f; qn2 = 0.f;
#pragma unroll
        for (int d0 = 0; d0 < 4; ++d0)
#pragma unroll
            for (int j = 0; j < 8; ++j) { qv[d0][j] = (float)qraw[d0][j]; ss += qv[d0][j] * qv[d0][j]; }
        ss = xsum32(ss);
        const float r = 1.0f / sqrtf(ss * (1.0f / HD) + EPS);
#pragma unroll
        for (int d0 = 0; d0 < 4; ++d0)
#pragma unroll
            for (int j = 0; j < 8; ++j) qv[d0][j] *= r * qgv[d0][j >> 2][j & 3];
        const float sc = 0.125f * LOG2E;
#pragma unroll
        for (int d0 = 0; d0 < 2; ++d0) {
            float o1[8], o2[8];
#pragma unroll
            for (int j = 0; j < 8; ++j) { const float cs = rcv[d0][j >> 2][j & 3], sn = rsv[d0][j >> 2][j & 3]; const float x1 = qv[d0][j], x2 = qv[d0 + 2][j];
                o1[j] = (x1 * cs - x2 * sn) * sc; o2[j] = (x2 * cs + x1 * sn) * sc; }
            u32x4 w1; w1.x = pkh(o1[0], o1[1]); w1.y = pkh(o1[2], o1[3]); w1.z = pkh(o1[4], o1[5]); w1.w = pkh(o1[6], o1[7]);
            u32x4 w2; w2.x = pkh(o2[0], o2[1]); w2.y = pkh(o2[2], o2[3]); w2.z = pkh(o2[4], o2[5]); w2.w = pkh(o2[6], o2[7]);
            qf[d0] = __builtin_bit_cast(h8, w1); qf[d0 + 2] = __builtin_bit_cast(h8, w2);
#pragma unroll
            for (int j = 0; j < 8; ++j) qn2 += o1[j] * o1[j] + o2[j] * o2[j];
        }
        qn2 = xsum32(qn2);
        {
            const float qn = sqrtf(qn2) * 8.0f * 1.001f; const float bs = qn * gm0, bw = qn * gm1; m_c = qn * gm2 - 13.0f;
            fastw = !ATT_FORCE_SLOW && __builtin_amdgcn_ballot_w64(!(bs <= 14.0f && bw <= 14.0f)) == 0ull;
            const half_t cs = (half_t)__builtin_amdgcn_exp2f(-fmaxf(ceilf(bs - 10.0f), 0.f)), cw = (half_t)__builtin_amdgcn_exp2f(-fmaxf(ceilf(bw - 10.0f), 0.f));
            const h2 c2s = {cs, cs}, c2w = {cw, cw}; ma = __builtin_bit_cast(unsigned, c2s); mb = __builtin_bit_cast(unsigned, c2w);
            m_sf = bs - 13.0f; m_wf = bw - 13.0f; }
    }
    if (!fastw && lane == 0) *SLOWF = 1u;
    __syncthreads();
    fast = (*SLOWF == 0u);
    {
        const LAS unsigned char* Kc = lds + A_CMPK + g * 16384; const LAS unsigned char* Vc = lds + A_CMPV + g * 16384;
        const int nmax = (t >= 31) ? ((t - 31) >> 4) : -1;
        const float mref = m_c; float lsum = 0.f, carry = 0.f;
        f32x16 oc[2]; oc[0] = f32x16{}; oc[1] = f32x16{};
#pragma unroll 1
        for (int T = 0; T < ntile; ++T) { f32x16 pc = qk_lds(Kc + T * 4096, qf, r32, hi);
#pragma unroll
            for (int r = 0; r < 16; ++r) { const int n = 32 * T + crow(r, hi); pc[r] = __builtin_amdgcn_exp2f((n > nmax ? -INFINITY : pc[r]) - mref); lsum += pc[r]; }
            pv_lds(oc, pc, Vc + T * 4096, vb);
#pragma unroll
            for (int gq = 0; gq < 4; ++gq) {
                const float own = (pc[4 * gq] + pc[4 * gq + 1]) + (pc[4 * gq + 2] + 0.5f * pc[4 * gq + 3]);
                const float prevk3 = gq > 0 ? pc[gq > 0 ? 4 * gq - 1 : 0] : carry;
                const float recv = xget32(hi == 0 ? pc[4 * gq + 3] : prevk3, hi);
                IMP[(h * 32 + 8 * T + 2 * gq + hi) * 32 + r32] = own + 0.5f * recv;
            }
            carry = pc[15];
        }
        lsum = xsum32(lsum);
        const float inv = (nmax >= 0) ? 1.0f / lsum : 0.f;
#pragma unroll 1
        for (int T = 0; T < ntile; ++T)
#pragma unroll
            for (int gq = 0; gq < 4; ++gq) { LAS float* p = IMP + (h * 32 + 8 * T + 2 * gq + hi) * 32 + r32; *p = *p * inv; }
        const float gci = g_c * inv;
#pragma unroll
        for (int r = 0; r < 16; ++r) { ot[0][r] = gci * oc[0][r]; ot[1][r] = gci * oc[1][r]; }
        { LAS unsigned char* rb = lds + A_KS0 + tg * 8192; *(LAS u32x4*)(rb + kdst0) = kr0; *(LAS u32x4*)(rb + 4096 + kdst0) = kr1; *(LAS u32x4*)(rb + 16384 + kdst0) = vr0; *(LAS u32x4*)(rb + 16384 + 4096 + kdst0) = vr1;
        }
        __syncthreads();
        LAS unsigned* SEL = (LAS unsigned*)(lds + A_SSQ + 1024);
        if (cur + 1 <= 8) sel = (1u << (cur + 1)) - 1u;
        else {
            const int q8 = 8 * (h & 3) + (lane >> 3), l8 = lane & 7; unsigned key[4];
#pragma unroll
            for (int i = 0; i < 4; ++i) { const int j = l8 + 8 * i; const LAS float* p = IMP + ((g * 4) * 32 + j) * 32 + q8; const float v = (p[0] + p[1024]) + (p[2048] + p[3072]);
                key[i] = (j >= 1 && j <= cur - 2) ? ((__float_as_uint(v) & ~31u) | (unsigned)(31 - j)) : 0u; }
            unsigned s_ = 1u | (1u << cur) | (1u << (cur - 1));
#pragma unroll
            for (int pass = 0; pass < 5; ++pass) {
                unsigned a01 = key[0] > key[1] ? key[0] : key[1], a23 = key[2] > key[3] ? key[2] : key[3]; unsigned best = a01 > a23 ? a01 : a23, o_;
                o_ = (unsigned)__builtin_amdgcn_update_dpp(0, (int)best, 0xB1, 0xF, 0xF, true); best = best > o_ ? best : o_;
                o_ = (unsigned)__builtin_amdgcn_update_dpp(0, (int)best, 0x4E, 0xF, 0xF, true); best = best > o_ ? best : o_;
                o_ = (unsigned)__builtin_amdgcn_update_dpp(0, (int)best, 0x141, 0xF, 0xF, true); best = best > o_ ? best : o_;
                s_ |= 1u << (31u - (best & 31u));
#pragma unroll
                for (int i = 0; i < 4; ++i) key[i] = key[i] == best ? 0u : key[i]; }
            if (l8 == 0) SEL[g * 32 + q8] = s_;
        }
        __syncthreads();
        if (tid == 0) *SLOWF = 0u;
        if (cur + 1 > 8) sel = SEL[g * 32 + r32];
        { LAS unsigned char* vb0_ = lds + A_VS0 + tg * 8192; *(LAS u32x4*)(vb0_ + vdst0) = vq0; *(LAS u32x4*)(vb0_ + 4096 + vdst0) = vq1; }
    }
    }
    LAS unsigned char* OT = lds + A_OT + h * 8192 + lane * 16;
#pragma unroll
    for (int q = 0; q < 8; ++q) { f32x4 v; v[0] = ot[q >> 2][4 * (q & 3)]; v[1] = ot[q >> 2][4 * (q & 3) + 1]; v[2] = ot[q >> 2][4 * (q & 3) + 2]; v[3] = ot[q >> 2][4 * (q & 3) + 3]; *(LAS f32x4*)(OT + q * 1024) = v; }
    {
        float l_s = 0.f, l_w = 0.f; f32x16 o[2]; o[0] = f32x16{}; o[1] = f32x16{};
        u32x4 kra, krb, vra, vrb;
        const __amdgpu_buffer_rsrc_t wsrs = __builtin_amdgcn_make_buffer_rsrc(F.ws, 0, 0x10000000, 0x00020000);
#define ATT_TILE_OFF(wsoff_s, wsoff_w, i) ((unsigned)((i) < n_s ? (unsigned)(wsoff_s) + (unsigned)(i) * (64u * HD * 2) : (unsigned)(wsoff_w) + (unsigned)(kt0w + (i) - n_s) * (64u * HD * 2)))
#define ATT_ISSUE_K2(i, KA, KB) do { const unsigned so_ = ATT_TILE_OFF(WS_KS, WS_KW, i); KA = __builtin_amdgcn_raw_buffer_load_b128(wsrs, kofb, so_, 0); KB = __builtin_amdgcn_raw_buffer_load_b128(wsrs, kofb + 4096u, so_, 0); } while (0)
#define ATT_ISSUE_V2(i, VA, VB) do { const unsigned so_ = ATT_TILE_OFF(WS_VS, WS_VW, i); VA = __builtin_amdgcn_raw_buffer_load_b128(wsrs, kofb, so_, 0); VB = __builtin_amdgcn_raw_buffer_load_b128(wsrs, kofb + 4096u, so_, 0); } while (0)
        ATT_ISSUE_K2(2, kra, krb);
        ATT_ISSUE_V2(1, vra, vrb);
        f32x16 c0 = qk_lds(lds + A_KS0 + g * 8192, qf, r32, hi), c1 = qk_lds(lds + A_KS0 + g * 8192 + 4096, qf, r32, hi);
        asm volatile("s_waitcnt lgkmcnt(0)" ::: "memory"); __builtin_amdgcn_s_barrier(); asm volatile("" ::: "memory");
        f32x16 d0, d1;
        u32x4 pw0 = {0u, 0u, 0u, 0u}, pw1 = pw0, pw2 = pw0, pw3 = pw0;
        s16x4 vl[8], vh[8];
#pragma unroll
        for (int m_ = 0; m_ < 8; ++m_) { vl[m_] = (s16x4){0, 0, 0, 0}; vh[m_] = (s16x4){0, 0, 0, 0}; }
        LAS unsigned char* const kst_p = lds + A_KS0 + tg * 8192 + kdst0; LAS unsigned char* const vst_p = lds + A_VS1 + tg * 8192 + vdst0;
        const LAS unsigned char* const vfr_p = lds + A_VS1 + g * 8192 + vb; const LAS unsigned char* kfr_p[4];
#pragma unroll
        for (int d0_ = 0; d0_ < 4; ++d0_) kfr_p[d0_] = lds + A_KS0 + g * 8192 + r32 * 128 + (((2 * d0_ + hi) ^ ((r32 >> 1) & 7)) << 4);
#define ATT_PIN(x) asm volatile("" : "+v"(x))
#define ATT_SB __builtin_amdgcn_sched_barrier(0)
#define ATT_VOFF(s_) ((s_) == 0 ? 0 : (s_) == 1 ? 1024 : (s_) == 2 ? 4096 : 5120)
#define ATT_VRD(m) do { vl[m] = vtr(vt_ + ((m) & 1) * 2048 + ATT_VOFF((m) >> 1)); vh[m] = vtr(vt_ + ((m) & 1) * 2048 + ATT_VOFF((m) >> 1) + 512); } while (0)
#define ATT_VF(m) __builtin_bit_cast(h8, __builtin_shufflevector(vl[m], vh[m], 0, 1, 2, 3, 4, 5, 6, 7))
#define ATT_KRD(m) do { kf[m] = *(const LAS h8*)(kfr_p[(m) >> 1] + kt_ + ((m) & 1) * 4096); } while (0)
#define ATT_EX2(C, e) do { C[e] = __builtin_amdgcn_exp2f(C[e]); C[(e) + 1] = __builtin_amdgcn_exp2f(C[(e) + 1]); } while (0)
#define ATT_AD2(C, e) do { } while (0)
#define ATT_PK2(C, e, W) do { const h2 w_ = __builtin_bit_cast(h2, pkh(C[e], C[(e) + 1])) * cpk; rsp += w_; W = __builtin_bit_cast(unsigned, w_); ATT_PIN(W); } while (0)
#define ATT_IT(j, PAR, C0, C1, N0, N1) do { \
            const bool is_s_ = (j) < n_s; const int kt_i = is_s_ ? (j) : kt0w + (j) - n_s, kb_i = 64 * kt_i; \
            if (__builtin_expect(kt_i == cur || (!is_s_ && kt_i == cur - 8), 0)) { \
                _Pragma("unroll") for (int r = 0; r < 16; ++r) { const int key = kb_i + crow(r, hi); if (key > t || key <= t - 512) C0[r] = -INFINITY; if (key + 32 > t || key + 32 <= t - 512) C1[r] = -INFINITY; } } \
            const bool en_ = is_s_ ? ((sel >> kt_i) & 1u) : true; const h2 cpk = __builtin_bit_cast(h2, en_ ? (is_s_ ? ma : mb) : 0u); h2 rsp = {(half_t)0.f, (half_t)0.f}; \
            const LAS unsigned char* vt_ = vfr_p + ((PAR) ? 0 : (A_VS0 - A_VS1));                    \
            constexpr int kt_ = (PAR) ? 0 : (A_KS1 - A_KS0);                                         \
            LAS unsigned char* kb_ = kst_p + ((PAR) ? (A_KS1 - A_KS0) : 0);                          \
            LAS unsigned char* vb_ = vst_p + ((PAR) ? (A_VS0 - A_VS1) : 0);                          \
            h8 kf[8]; \
            const h8 p0_ = __builtin_bit_cast(h8, pw0), p1_ = __builtin_bit_cast(h8, pw1), p2_ = __builtin_bit_cast(h8, pw2), p3_ = __builtin_bit_cast(h8, pw3); \
            ATT_SB; \
            o[0] = MFMA32(ATT_VF(0), p0_, o[0]); ATT_KRD(0); ATT_EX2(C0, 0); *(LAS u32x4*)(kb_) = kra; ATT_SB; \
            o[1] = MFMA32(ATT_VF(1), p0_, o[1]); ATT_KRD(1); ATT_EX2(C0, 2); ATT_AD2(C0, 0); *(LAS u32x4*)(kb_ + 4096) = krb; ATT_SB; \
            o[0] = MFMA32(ATT_VF(2), p1_, o[0]); ATT_KRD(2); ATT_EX2(C0, 4); ATT_AD2(C0, 2); ATT_PK2(C0, 0, pw0.x); *(LAS u32x4*)(vb_) = vra; ATT_SB; \
            o[1] = MFMA32(ATT_VF(3), p1_, o[1]); ATT_KRD(3); ATT_EX2(C0, 6); ATT_AD2(C0, 4); ATT_PK2(C0, 2, pw0.y); *(LAS u32x4*)(vb_ + 4096) = vrb; ATT_SB; \
            o[0] = MFMA32(ATT_VF(4), p2_, o[0]); ATT_KRD(4); ATT_EX2(C0, 8); ATT_AD2(C0, 6); ATT_PK2(C0, 4, pw0.z); ATT_ISSUE_K2((j) + 3, kra, krb); ATT_SB; \
            o[1] = MFMA32(ATT_VF(5), p2_, o[1]); ATT_KRD(5); ATT_EX2(C0, 10); ATT_AD2(C0, 8); ATT_PK2(C0, 6, pw0.w); ATT_ISSUE_V2((j) + 2, vra, vrb); ATT_SB; \
            o[0] = MFMA32(ATT_VF(6), p3_, o[0]); ATT_KRD(6); ATT_EX2(C0, 12); ATT_AD2(C0, 10); ATT_PK2(C0, 8, pw1.x); ATT_SB; \
            o[1] = MFMA32(ATT_VF(7), p3_, o[1]); ATT_KRD(7); ATT_EX2(C0, 14); ATT_AD2(C0, 12); ATT_PK2(C0, 10, pw1.y); ATT_SB; \
            N0 = MFMA32(kf[0], qf[0], (f32x16){}); ATT_VRD(0); ATT_EX2(C1, 0); ATT_AD2(C0, 14); ATT_PK2(C0, 12, pw1.z); ATT_SB; \
            N1 = MFMA32(kf[1], qf[0], (f32x16){}); ATT_VRD(1); ATT_EX2(C1, 2); ATT_AD2(C1, 0); ATT_PK2(C0, 14, pw1.w); ATT_SB; \
            N0 = MFMA32(kf[2], qf[1], N0); ATT_VRD(2); ATT_EX2(C1, 4); ATT_AD2(C1, 2); ATT_PK2(C1, 0, pw2.x); ATT_SB; \
            N1 = MFMA32(kf[3], qf[1], N1); ATT_VRD(3); ATT_EX2(C1, 6); ATT_AD2(C1, 4); ATT_PK2(C1, 2, pw2.y); ATT_SB; \
            N0 = MFMA32(kf[4], qf[2], N0); ATT_VRD(4); ATT_EX2(C1, 8); ATT_AD2(C1, 6); ATT_PK2(C1, 4, pw2.z); ATT_SB; \
            N1 = MFMA32(kf[5], qf[2], N1); ATT_VRD(5); ATT_EX2(C1, 10); ATT_AD2(C1, 8); ATT_PK2(C1, 6, pw2.w); ATT_SB; \
            N0 = MFMA32(kf[6], qf[3], N0); ATT_VRD(6); ATT_EX2(C1, 12); ATT_AD2(C1, 10); ATT_PK2(C1, 8, pw3.x); ATT_SB; \
            N1 = MFMA32(kf[7], qf[3], N1); ATT_VRD(7); ATT_EX2(C1, 14); ATT_AD2(C1, 12); ATT_PK2(C1, 10, pw3.y); ATT_SB; \
            ATT_AD2(C1, 14); ATT_PK2(C1, 12, pw3.z); ATT_PK2(C1, 14, pw3.w); \
            { const float rs = (float)rsp[0] + (float)rsp[1]; l_s += is_s_ ? rs : 0.f; l_w += is_s_ ? 0.f : rs; } \
            __syncthreads(); } while (0)
#define ATT_FIN_SEL do { const float f_ = gt[1] / xsum32(l_s); \
          _Pragma("unroll") for (int q = 0; q < 8; ++q) { f32x4 v_ = *(LAS f32x4*)(OT + q * 1024); \
              _Pragma("unroll") for (int e = 0; e < 4; ++e) { v_[e] += f_ * o[q >> 2][4 * (q & 3) + e]; o[q >> 2][4 * (q & 3) + e] = 0.f; } *(LAS f32x4*)(OT + q * 1024) = v_; } } while (0)
        if (fast) {
        int j = 0;
#pragma unroll 1
        for (; j + 1 <= n_s; j += 2) { ATT_IT(j, 0, c0, c1, d0, d1); ATT_IT(j + 1, 1, d0, d1, c0, c1); }
        if (j <= n_s) { ATT_IT(j, 0, c0, c1, d0, d1); ++j; }
        ATT_FIN_SEL;
        if ((j & 1) && j < nsteps) { ATT_IT(j, 1, d0, d1, c0, c1); ++j; }
#pragma unroll 1
        for (; j < nsteps; j += 2) { ATT_IT(j, 0, c0, c1, d0, d1); if (j + 1 < nsteps) ATT_IT(j + 1, 1, d0, d1, c0, c1); }
        } else {
#pragma unroll 1
            for (int j = 0; j < nsteps; ++j) {
                const bool is_s_ = j < n_s; const int kt_i = is_s_ ? j : kt0w + j - n_s, kb_i = 64 * kt_i;
                const unsigned ko_ = ATT_TILE_OFF(WS_KS, WS_KW, j), vo_ = ATT_TILE_OFF(WS_VS, WS_VW, j);
                const u32x4 ka_ = __builtin_amdgcn_raw_buffer_load_b128(wsrs, kofb, ko_, 0), kb2_ = __builtin_amdgcn_raw_buffer_load_b128(wsrs, kofb + 4096u, ko_, 0);
                const u32x4 va_ = __builtin_amdgcn_raw_buffer_load_b128(wsrs, kofb, vo_, 0), vb2_ = __builtin_amdgcn_raw_buffer_load_b128(wsrs, kofb + 4096u, vo_, 0);
                *(LAS u32x4*)(kst_p) = ka_; *(LAS u32x4*)(kst_p + 4096) = kb2_;
                *(LAS u32x4*)(vst_p + (A_VS0 - A_VS1)) = va_; *(LAS u32x4*)(vst_p + (A_VS0 - A_VS1) + 4096) = vb2_;
                __syncthreads();
                const bool en_ = is_s_ ? ((sel >> kt_i) & 1u) : true; const float msub = en_ ? (is_s_ ? m_sf : m_wf) : INFINITY; float rs = 0.f;
#pragma unroll 1
                for (int hf = 0; hf < 2; ++hf) {
                    f32x16 sc = qk_lds(lds + A_KS0 + g * 8192 + hf * 4096, qf, r32, hi);
#pragma unroll
                    for (int r = 0; r < 16; ++r) { const int key = kb_i + 32 * hf + crow(r, hi); const float v_ = (key > t || (!is_s_ && key <= t - 512)) ? -INFINITY : sc[r];
                        const float p_ = __builtin_amdgcn_exp2f(v_ - msub); sc[r] = p_; rs += p_; }
                    pv_lds(o, sc, lds + A_VS0 + g * 8192 + hf * 4096, vb);
                }
                l_s += is_s_ ? rs : 0.f; l_w += is_s_ ? 0.f : rs;
                if (j == n_s - 1) ATT_FIN_SEL;
                __syncthreads();
            }
        }
#undef ATT_FIN_SEL
        {
            const h8 p0_ = __builtin_bit_cast(h8, pw0), p1_ = __builtin_bit_cast(h8, pw1), p2_ = __builtin_bit_cast(h8, pw2), p3_ = __builtin_bit_cast(h8, pw3);
            o[0] = MFMA32(ATT_VF(0), p0_, o[0]); o[1] = MFMA32(ATT_VF(1), p0_, o[1]); o[0] = MFMA32(ATT_VF(2), p1_, o[0]); o[1] = MFMA32(ATT_VF(3), p1_, o[1]);
            o[0] = MFMA32(ATT_VF(4), p2_, o[0]); o[1] = MFMA32(ATT_VF(5), p2_, o[1]); o[0] = MFMA32(ATT_VF(6), p3_, o[0]); o[1] = MFMA32(ATT_VF(7), p3_, o[1]);
        }
#undef ATT_IT
#undef ATT_EX2
#undef ATT_AD2
#undef ATT_PK2
#undef ATT_VRD
#undef ATT_VF
#undef ATT_KRD
#undef ATT_ISSUE_K2
#undef ATT_ISSUE_V2
#undef ATT_TILE_OFF
        const float f = gt[2] / xsum32(l_w);
#pragma unroll
        for (int q = 0; q < 8; ++q) { const f32x4 v = *(LAS f32x4*)(OT + q * 1024);
#pragma unroll
            for (int e = 0; e < 4; ++e) ot[q >> 2][4 * (q & 3) + e] = v[e] + f * o[q >> 2][4 * (q & 3) + e]; }
    }
    {
        const float* og = a.in[17] + h * HD; f32x4 gv[8];
#pragma unroll
        for (int q = 0; q < 8; ++q) gv[q] = *(const f32x4*)(og + 32 * (q >> 2) + 8 * (q & 3) + 4 * hi);
        float ss = 0.f;
#pragma unroll
        for (int r = 0; r < 16; ++r) ss += ot[0][r] * ot[0][r] + ot[1][r] * ot[1][r];
        ss = xsum32(ss);
        if (hi == 0) SSQ8[h * 32 + r32] = ss;
        __syncthreads();
        float tot = 0.f;
#pragma unroll
        for (int hh = 0; hh < 8; ++hh) tot += SSQ8[hh * 32 + r32];
        const float rn = 1.0f / sqrtf(tot * (1.0f / NSA_W) + EPS);
        half_t* dst = (half_t*)(F.ws + WS_MIX) + row * D_MODEL + h * HD;
        u32x2 o2[8];
#pragma unroll
        for (int dh = 0; dh < 2; ++dh)
#pragma unroll
            for (int q4 = 0; q4 < 4; ++q4) { const f32x4 g4 = gv[dh * 4 + q4];
                o2[dh * 4 + q4].x = PKM(ot[dh][4 * q4] * rn * g4[0], ot[dh][4 * q4 + 1] * rn * g4[1]); o2[dh * 4 + q4].y = PKM(ot[dh][4 * q4 + 2] * rn * g4[2], ot[dh][4 * q4 + 3] * rn * g4[3]); }
#pragma unroll
        for (int k = 0; k < 8; k += 2) { const auto r0 = __builtin_amdgcn_permlane32_swap(o2[k].x, o2[k + 1].x, false, false), r1 = __builtin_amdgcn_permlane32_swap(o2[k].y, o2[k + 1].y, false, false);
            u32x4 w; w.x = r0[0]; w.y = r1[0]; w.z = r0[1]; w.w = r1[1];
            *(u32x4*)(dst + 8 * k + 8 * hi) = w; }
        __syncthreads();
    }
}

__device__ __forceinline__ void grp_publish(unsigned* cnt) {
    asm volatile("s_waitcnt vmcnt(0)" ::: "memory"); __syncthreads();
    if (threadIdx.x == 0) __hip_atomic_fetch_add(cnt, 1u, __ATOMIC_RELAXED, __HIP_MEMORY_SCOPE_AGENT);
}
__device__ __forceinline__ void grp_wait(unsigned* cnt, unsigned want) {
    if (threadIdx.x == 0) { unsigned sp = 0;
        while (__hip_atomic_load(cnt, __ATOMIC_RELAXED, __HIP_MEMORY_SCOPE_AGENT) < want) { __builtin_amdgcn_s_sleep(2); if (++sp > (1u << 21)) break; }
        __builtin_amdgcn_fence(__ATOMIC_ACQUIRE, "agent"); asm volatile("s_waitcnt vmcnt(0)" ::: "memory"); }
    __syncthreads();
}
__global__ void __launch_bounds__(NWAVES * 64, 2) fwd_kernel(Args args) {
    extern __shared__ __attribute__((aligned(16))) unsigned char lds_raw[];
    Frame F;
    F.lds = (LAS unsigned char*)lds_raw;
    F.tid = threadIdx.x; F.lane = F.tid & 63; F.wave = __builtin_amdgcn_readfirstlane(F.tid >> 6);
    F.G = gridDim.x; { const int bx = blockIdx.x; F.vcu = (F.G % 8 == 0) ? (bx % 8) * (F.G / 8) + bx / 8 : bx; }
    F.ws = args.ws;
    volatile LAS unsigned* MISC = (volatile LAS unsigned*)(F.lds + MISC_OFF);
    for (int u = F.tid; u < (LDS_BYTES - LDSCTL_OFF) / 4; u += NWAVES * 64) ((LAS unsigned*)(F.lds + LDSCTL_OFF))[u] = 0u;
    __syncthreads();
    unsigned* ctl = (unsigned*)(args.ws + WS_CTL);
    XcdBarrier bar = xcd_barrier_post(ctl + CW_BAR + args.li * XCD_BAR_WORDS, MISC + 8);
    const unsigned cls_k = blockIdx.x & 7u; unsigned* const cls_mask = ctl + 28160 + 64 * cls_k;
    ClsBarrier cbar{ctl + 28672 + 128 * cls_k, ctl + 28672 + 128 * cls_k + 64, ctl + CW_BAR + args.li * XCD_BAR_WORDS + XB_TMO, (gridDim.x + 7u - cls_k) / 8u, false};
    if (threadIdx.x == 0) __hip_atomic_fetch_or(cls_mask, 1u << bar.x, __ATOMIC_RELAXED, __HIP_MEMORY_SCOPE_AGENT);
    bool use_cls = false;
    const int lo = args.ph_lo, hi = args.ph_hi;
#ifdef ONLY_PHASE
#define IN(k) ((k) == ONLY_PHASE && lo <= (k) && (k) < hi)
#else
#define IN(k) (lo <= (k) && (k) < hi)
#endif
#define SEAM(k) do { if (IN(k) && IN((k) + 1)) xcd_barrier(bar); } while (0)
#define SEAM_CLS(k) do { if (IN(k) && IN((k) + 1)) { if (use_cls) cls_barrier(cbar); else xcd_barrier(bar); } } while (0)
    half_t* const wsH = (half_t*)args.ws;
#define WSH(off) ((half_t*)(args.ws + (off)))

#define RUN2(k, ...) do { if (IN(k)) { __VA_ARGS__ if (DUP_PHASE == (k)) { __VA_ARGS__ } } } while (0)
    RUN2(0, { p0_prologue(F, args, F.G == 256 ? 1 : 3); });
    SEAM(0);
    if (F.G == 256 && lo == 0) {
        const unsigned m_ = __hip_atomic_load(cls_mask, __ATOMIC_RELAXED, __HIP_MEMORY_SCOPE_AGENT);
        use_cls = true; cbar.same = (__builtin_popcount(m_) == 1);
    }
    RUN2(1, {
        pg8::Gemm g{WSH(WS_XN), WSH(WS_WIN), M, IN_PAD, 1024, 1024, 1024}; pg8::StaticOrder S; S.init(M, IN_PAD, F.G, (int)blockIdx.x);
        pg8::EpiInProj E{args.ws};
        if (F.G == 256 && (int)blockIdx.x >= 128) { const int wi_ = ((int)blockIdx.x - 128) * NWAVES + F.wave;
            p0_prologue(F, args, 2, 128 * NWAVES - 1 - wi_, 128 * NWAVES);
            late_weights(F, args, wi_, 128 * NWAVES, 0, 1 << 30); __syncthreads(); }
        pg8::gemm_phase<pg8::EpiInProj, pg8::StaticOrder, true, IN_BF16 != 0>(F.lds, g, S, E);
        if (F.G != 256) late_weights(F, args, (int)blockIdx.x * NWAVES + F.wave, F.G * NWAVES, 0, 1 << 30);
    });
    SEAM(1);
    RUN2(2, {
        if (F.G == 256) {
            const int c = (int)blockIdx.x;
            if (c < 128) {
                const int kv = c >> 6, pmu = (c >> 3) & 7, ks = c & 7; unsigned* cnt = (unsigned*)(args.ws + WS_CTL + 122880) + 64 * (c >> 3);
                pg8::Gemm gk{WSH(WS_KC) + (size_t)kv * (KV6_STRIDE / 2) + (size_t)pmu * 256 * 1024 + ks * 256, WSH(WS_W1K) + (size_t)kv * ((WS_W1V - WS_W1K) / 2) + ks * 256, 256, 256, 256, 1024, 2048};
                pg8::SingleOrder Sk{true};
                pg8::EpiF32W Ek{args.ws, (unsigned)(WS_HIDP + ((size_t)(kv * 8 + ks) * 2048 + pmu * 256) * CMP_HID * 4), CMP_HID};
                pg8::gemm_phase<pg8::EpiF32W, pg8::SingleOrder, false>(F.lds, gk, Sk, Ek);
                grp_publish(cnt);
                conv_half(F, args, c);
                cmp_finalize_wg(F, args, 16 * c, kv, [&]() __attribute__((always_inline)) { grp_wait(cnt, 8u); });
            } else {
                conv_halves(F, args, 128 + 3 * (c - 128), 3);
                kprep(F, args, (c - 128) * NWAVES + F.wave, 128 * NWAVES);
            }
        } else {
            for (int it = F.vcu; it < M / 64; it += F.G) conv_item(F, args, it);
            kprep(F, args, F.vcu * NWAVES + F.wave, F.G * NWAVES);
            __syncthreads();
            const int c = (int)blockIdx.x; const int kv = (c >> 6) & 1, pmu = (c >> 3) & 7, ks = c & 7;
            pg8::Gemm gk{WSH(WS_KC) + (size_t)kv * (KV6_STRIDE / 2) + (size_t)pmu * 256 * 1024 + ks * 256, WSH(WS_W1K) + (size_t)kv * ((WS_W1V - WS_W1K) / 2) + ks * 256, 256, 256, 256, 1024, 2048};
            pg8::SingleOrder Sk{c < 128};
            pg8::EpiF32 Ek{(float*)(args.ws + WS_HIDP) + ((size_t)(kv * 8 + ks) * 2048 + pmu * 256) * CMP_HID, CMP_HID};
            pg8::gemm_phase<pg8::EpiF32, pg8::SingleOrder, false>(F.lds, gk, Sk, Ek);
        }
    });
    SEAM(2);
    if (F.G != 256) {
        RUN2(3, { cmp_finalize<false>(F, args, F.vcu * NWAVES + F.wave, F.G * NWAVES, 2 * 16 * (NCMP_PAD / 2), -1); });
        SEAM(3);
    }
    RUN2(4, {
        for (int it = F.vcu; it < 512; it += F.G) { const int v = it & 255; const int b = v >> 5; const int s = v & 31; attn_item(F, args, b, it < 256 ? s : 63 - s); }
    });
    if (F.G == 256 && IN(5)) {
        pg8::Gemm g{WSH(WS_MIX), WSH(WS_WOUT), M, 1024, 1024, 1024, 1024}; pg8::StaticOrder S; S.init(M, 1024, F.G, (int)blockIdx.x);
        pg8::EpiOutProj E{args.in[0], WSH(WS_H1H), (float*)(args.ws + WS_SSQ), true};
        SeamPre sp{cbar, bar, use_cls, IN(4) && IN(5), 0u};
        pg8::gemm_phase_i<pg8::EpiOutProj, pg8::StaticOrder, false, MIX_BF16 != 0, false, true, SeamPre>(F.lds, g, S, E, sp);
    } else {
    SEAM_CLS(4);
    RUN2(5, {
        pg8::Gemm g{WSH(WS_MIX), WSH(WS_WOUT), M, 1024, 1024, 1024, 1024}; pg8::StaticOrder S; S.init(M, 1024, F.G, (int)blockIdx.x);
        pg8::EpiOutProj E{args.in[0], WSH(WS_H1H), (float*)(args.ws + WS_SSQ), false};
        pg8::gemm_phase<pg8::EpiOutProj, pg8::StaticOrder, false, MIX_BF16 != 0>(F.lds, g, S, E);
    });
    }
    SEAM_CLS(5);
    RUN2(6, {
        pg8::Gemm g{WSH(WS_H1H), WSH(WS_WGU), M, 2 * FFN, 1024, 1024, 1024}; pg8::StaticOrder S; S.init(M, 2 * FFN, F.G, (int)blockIdx.x);
        LAS float* RT = (LAS float*)(F.lds + RING_BYTES);
        { const float* SSQ = (const float*)(args.ws + WS_SSQ);
          for (int idx = F.tid; idx < 8 * 256; idx += NWAVES * 64) { const int row = (8 * ((int)blockIdx.x & 7) + (idx >> 8)) * 256 + (idx & 255); const f32x4 sq = *(const f32x4*)(SSQ + (size_t)row * 4);
              RT[idx] = __builtin_amdgcn_rsqf(((sq[0] + sq[1]) + (sq[2] + sq[3])) * (1.0f / D_MODEL) + EPS); }
          __syncthreads(); }
        if (F.G == 256) {
            S.maxr = 5;
            pg8::EpiGateUp E{RT, args.ws, false};
            pg8::gemm_phase<pg8::EpiGateUp, pg8::StaticOrder, true, FFN_BF16 != 0>(F.lds, g, S, E);
            pg8::TailHalfOrder T{S, 5}; T.S.maxr = 1 << 30;
            pg8::EpiGateUp Eh{RT, args.ws, true};
            pg8::gemm_phase<pg8::EpiGateUp, pg8::TailHalfOrder, false, FFN_BF16 != 0, true>(F.lds, g, T, Eh);
        } else {
            pg8::EpiGateUp E{RT, args.ws, false};
            pg8::gemm_phase<pg8::EpiGateUp, pg8::StaticOrder, true, FFN_BF16 != 0>(F.lds, g, S, E);
        }
    });
    if (F.G == 256 && IN(7)) {
        pg8::Gemm g{WSH(WS_HB), WSH(WS_WDN), M, 1024, FFN, FFN, FFN}; pg8::StaticOrder S; S.init(M, 1024, F.G, (int)blockIdx.x);
        pg8::EpiDown E{WSH(WS_H1H), args.out, true};
        SeamPre sp{cbar, bar, use_cls, IN(6) && IN(7), 0u};
        pg8::gemm_phase_i<pg8::EpiDown, pg8::StaticOrder, false, FFN_BF16 != 0, false, true, SeamPre>(F.lds, g, S, E, sp);
    } else {
    SEAM_CLS(6);
    RUN2(7, {
        pg8::Gemm g{WSH(WS_HB), WSH(WS_WDN), M, 1024, FFN, FFN, FFN}; pg8::StaticOrder S; S.init(M, 1024, F.G, (int)blockIdx.x);
        pg8::EpiDown E{WSH(WS_H1H), args.out, false};
        pg8::gemm_phase<pg8::EpiDown, pg8::StaticOrder, false, FFN_BF16 != 0>(F.lds, g, S, E);
    });
    }
#undef RUN2
    (void)wsH;
#undef IN
#undef SEAM
#undef WSH
}

extern "C" void kernel_launch(void* const* d_in, const int* in_sizes, int n_in, void* d_out, int out_size, void* d_ws, size_t ws_size, hipStream_t stream) {
    static int grid = 0;
    if (grid == 0) {
        if (n_in != 23 || in_sizes[0] != M * D_MODEL || out_size != M * D_MODEL || ws_size < WS_END) { fprintf(stderr, "kernel_launch: unexpected shapes (n_in %d, in0 %d, out %d, ws %zu)\n", n_in, n_in > 0 ? in_sizes[0] : -1, out_size, ws_size); grid = -1; return; }
        int dev = 0, cus = 0;
        if (hipGetDevice(&dev) != hipSuccess || hipDeviceGetAttribute(&cus, hipDeviceAttributeMultiprocessorCount, dev) != hipSuccess) { grid = -1; return; }
        if (hipFuncSetAttribute((const void*)fwd_kernel, hipFuncAttributeMaxDynamicSharedMemorySize, LDS_BYTES) != hipSuccess) { fprintf(stderr, "kernel_launch: hipFuncSetAttribute failed\n"); grid = -1; return; }
        int per_cu = 0;
        if (hipOccupancyMaxActiveBlocksPerMultiprocessor(&per_cu, (const void*)fwd_kernel, NWAVES * 64, LDS_BYTES) != hipSuccess || per_cu < 1) fprintf(stderr, "kernel_launch: occupancy query says %d\n", per_cu);
        (void)hipGetLastError();
        grid = cus;
        if (grid != 256) fprintf(stderr, "kernel_launch: %d CUs (built for 256)\n", grid);
    }
    if (grid < 0) return;
    (void)hipMemsetAsync((char*)d_ws + WS_CTL, 0, CTL_ZERO_BYTES, stream);
    Args a{};
    for (int i = 0; i < 23; ++i) a.in[i] = (const float*)d_in[i];
    a.out = (float*)d_out; a.ws = (unsigned char*)d_ws;
#if MK_N_LAUNCHES == 1
    a.ph_lo = 0; a.ph_hi = N_PHASES; a.li = 0;
    hipLaunchKernelGGL(fwd_kernel, dim3(grid), dim3(NWAVES * 64), LDS_BYTES, stream, a);
#else
    for (int p = 0; p < N_PHASES; ++p) { a.ph_lo = p; a.ph_hi = p + 1; a.li = p; hipLaunchKernelGGL(fwd_kernel, dim3(grid), dim3(NWAVES * 64), LDS_BYTES, stream, a); }
#endif
}
```
